# Optimizing an MI355X kernel written in HIP

```python
import math
import jax, jax.numpy as jnp
from jax import lax
import numpy as np

D_MODEL = 4096
BATCH = 2
SEQ = 8192
DEPTH = 2

HEAD_DIM = 128
A_WIDTH = D_MODEL // 4
A_HEADS = A_WIDTH // HEAD_DIM
A_BRANCHES = ((128, 1), (512, 4), (2048, 16))
B_WIDTH = D_MODEL // 4
CONV_WIDTH = 3
C_WIDTH = D_MODEL // 2
C_HEADS = C_WIDTH // HEAD_DIM
C_KV_HEADS = C_HEADS // 4
C_KV_WIDTH = C_KV_HEADS * HEAD_DIM
Q_BLOCK = 128
ROPE_THETA = 10000.0
GRID_W = 64
NUM_BUCKETS = 32
MAX_DISTANCE = 1024
D_FF = 4 * D_MODEL
EPS = 1e-6
NEG = -1e30

MIX_WIDTH = A_WIDTH + B_WIDTH + C_WIDTH
IN_SIZES = (A_WIDTH, A_WIDTH, A_WIDTH, B_WIDTH, B_WIDTH, B_WIDTH, C_WIDTH, C_KV_WIDTH, C_KV_WIDTH)
IN_WIDTH = sum(IN_SIZES)
IN_SPLITS = tuple(int(v) for v in np.cumsum(IN_SIZES)[:-1])

kernel_name = 'hybrid_parallel_mixer_encoder'


def rms_norm(x, g):
    xf = x.astype(jnp.float32)
    y = xf * lax.rsqrt(jnp.mean(xf * xf, axis=-1, keepdims=True) + EPS)
    return (y * g.astype(jnp.float32)).astype(x.dtype)


def t5_bucket(rel):
    half = NUM_BUCKETS // 2
    max_exact = half // 2
    n = jnp.abs(rel)
    base = jnp.where(rel > 0, half, 0)
    nf = jnp.maximum(n, 1).astype(jnp.float32)
    large = max_exact + (jnp.log(nf / max_exact) / math.log(MAX_DISTANCE / max_exact) * (half - max_exact)).astype(jnp.int32)
    large = jnp.minimum(large, half - 1)
    return base + jnp.where(n < max_exact, n, large)


def dilated_branch(q, k, v, rel_bias, window, dilation):
    b, h, s, dh = q.shape
    span = window // (2 * dilation)
    L = s // dilation
    nb = -(-L // span)
    pad = nb * span - L

    def fold(t):
        return t.reshape(b, h, L, dilation, dh).transpose(0, 1, 3, 2, 4)

    qf = jnp.pad(fold(q), ((0, 0), (0, 0), (0, 0), (0, pad), (0, 0)))
    kf = jnp.pad(fold(k), ((0, 0), (0, 0), (0, 0), (span, pad + span), (0, 0)))
    vf = jnp.pad(fold(v), ((0, 0), (0, 0), (0, 0), (span, pad + span), (0, 0)))
    qb = qf.reshape(b, h, dilation, nb, span, dh)

    def windows(t):
        tb = t.reshape(b, h, dilation, nb + 2, span, dh)
        return jnp.concatenate([tb[:, :, :, :-2], tb[:, :, :, 1:-1], tb[:, :, :, 2:]], axis=4)

    kw, vw = windows(kf), windows(vf)
    logits = jnp.einsum('bhrnqd,bhrnkd->bhrnqk', qb, kw).astype(jnp.float32)
    qi = jnp.arange(span)
    ki = jnp.arange(3 * span)
    rel = ki[None, :] - span - qi[:, None]
    bias = rel_bias.astype(jnp.float32)[t5_bucket(rel * dilation)]
    bias = jnp.transpose(bias, (2, 0, 1))
    key_pos = jnp.arange(nb)[:, None] * span + ki[None, :] - span
    valid = (jnp.abs(rel)[None] <= span) & (key_pos[:, None, :] >= 0) & (key_pos[:, None, :] < L)
    logits = jnp.where(valid[None, None, None], logits + bias[None, :, None, None], NEG)
    m = jnp.max(logits, axis=-1, keepdims=True)
    p = jnp.exp(logits - m)
    l = jnp.sum(p, axis=-1, keepdims=True)
    o = jnp.einsum('bhrnqk,bhrnkd->bhrnqd', p, vw.astype(jnp.float32)) / l
    lse = (m + jnp.log(l))[..., 0]
    o = o.reshape(b, h, dilation, nb * span, dh)[:, :, :, :L].transpose(0, 1, 3, 2, 4).reshape(b, h, s, dh)
    lse = lse.reshape(b, h, dilation, nb * span)[:, :, :, :L].transpose(0, 1, 3, 2).reshape(b, h, s)
    return o, lse


def dilated_mixer(q, k, v, rel_bias):
    b, s = q.shape[:2]
    qt = q.transpose(0, 2, 1, 3) * (HEAD_DIM ** -0.5)
    kt = k.transpose(0, 2, 1, 3)
    vt = v.transpose(0, 2, 1, 3)
    outs, lses = [], []
    for window, dilation in A_BRANCHES:
        o, lse = dilated_branch(qt, kt, vt, rel_bias, window, dilation)
        outs.append(o)
        lses.append(lse)
    wts = jax.nn.softmax(jnp.stack(lses), axis=0)
    o = jnp.sum(wts[..., None] * jnp.stack(outs), axis=0)
    return o.transpose(0, 2, 1, 3).reshape(b, s, A_WIDTH).astype(q.dtype)


def short_conv_mixer(gate_b, gate_c, h, conv_w):
    u = gate_c * h
    y = lax.conv_general_dilated(u, conv_w[:, None, :].astype(u.dtype), window_strides=(1,),
                                 padding=((CONV_WIDTH // 2, CONV_WIDTH // 2),),
                                 dimension_numbers=('NWC', 'WIO', 'NWC'),
                                 feature_group_count=u.shape[-1])
    return gate_b * y


def rope_1d(xh, pos):
    quarter = xh.shape[-1] // 2
    inv = ROPE_THETA ** (-jnp.arange(quarter, dtype=jnp.float32) / quarter)
    ang = pos.astype(jnp.float32)[:, None] * inv[None, :]
    c = jnp.cos(ang)[None, :, None, :]
    sn = jnp.sin(ang)[None, :, None, :]
    x1 = xh[..., :quarter].astype(jnp.float32)
    x2 = xh[..., quarter:].astype(jnp.float32)
    return jnp.concatenate([x1 * c - x2 * sn, x2 * c + x1 * sn], axis=-1)


def axial_rope(x, row, col):
    half = HEAD_DIM // 2
    return jnp.concatenate([rope_1d(x[..., :half], row), rope_1d(x[..., half:], col)], axis=-1).astype(x.dtype)


def axial_gqa_mixer(q, k, v, q_gain, k_gain):
    b, s = q.shape[:2]
    rows = s // GRID_W
    row = jnp.repeat(jnp.arange(rows), GRID_W)
    col = jnp.tile(jnp.arange(GRID_W), rows)
    q = axial_rope(rms_norm(q, q_gain), row, col) * (HEAD_DIM ** -0.5)
    k = axial_rope(rms_norm(k, k_gain), row, col)
    g = C_HEADS // C_KV_HEADS
    nb = s // Q_BLOCK
    qb = q.reshape(b, nb, Q_BLOCK, C_KV_HEADS, g, HEAD_DIM).transpose(1, 0, 3, 4, 2, 5)
    kt = k.transpose(0, 2, 1, 3)
    vt = v.transpose(0, 2, 1, 3)

    def block(qblk):
        logits = jnp.einsum('bkgqd,bksd->bkgqs', qblk, kt).astype(jnp.float32)
        p = jax.nn.softmax(logits, axis=-1)
        return jnp.einsum('bkgqs,bksd->bkgqd', p, vt.astype(jnp.float32))

    o = lax.map(block, qb)
    return o.transpose(1, 0, 4, 2, 3, 5).reshape(b, s, C_WIDTH).astype(q.dtype)


def setup_inputs(seed: int = 0) -> dict:
    key = jax.random.key(seed)
    ks = jax.random.split(key, 17)
    f32 = jnp.float32

    def gain(k, shape):
        return 1.0 + 0.02 * jax.random.normal(k, shape, f32)

    return {
        'x': jax.random.normal(ks[0], (BATCH, SEQ, D_MODEL), f32),
        'rel_bias': 0.2 * jax.random.normal(ks[1], (NUM_BUCKETS, A_HEADS), f32),
        'pre_mix_norm': gain(ks[2], (DEPTH, D_MODEL)),
        'w_in': jax.random.normal(ks[3], (DEPTH, D_MODEL, IN_WIDTH), f32) * D_MODEL ** -0.5,
        'conv_w': jax.random.normal(ks[4], (DEPTH, CONV_WIDTH, B_WIDTH), f32) * CONV_WIDTH ** -0.5,
        'q_norm': gain(ks[5], (DEPTH, HEAD_DIM)),
        'k_norm': gain(ks[6], (DEPTH, HEAD_DIM)),
        'out_norm_a': gain(ks[7], (DEPTH, A_WIDTH)),
        'out_norm_b': gain(ks[8], (DEPTH, B_WIDTH)),
        'out_norm_c': gain(ks[9], (DEPTH, C_WIDTH)),
        'w_out': jax.random.normal(ks[10], (DEPTH, MIX_WIDTH, D_MODEL), f32) * MIX_WIDTH ** -0.5,
        'post_mix_norm': gain(ks[11], (DEPTH, D_MODEL)),
        'pre_mlp_norm': gain(ks[12], (DEPTH, D_MODEL)),
        'w_up': jax.random.normal(ks[13], (DEPTH, D_MODEL, D_FF), f32) * D_MODEL ** -0.5,
        'w_down': jax.random.normal(ks[14], (DEPTH, D_FF, D_MODEL), f32) * D_FF ** -0.5,
        'post_mlp_norm': gain(ks[15], (DEPTH, D_MODEL)),
    }


def reference(x, rel_bias, pre_mix_norm, w_in, conv_w, q_norm, k_norm, out_norm_a, out_norm_b,
              out_norm_c, w_out, post_mix_norm, pre_mlp_norm, w_up, w_down, post_mlp_norm):
    b, s, _ = x.shape
    for i in range(DEPTH):
        hn = rms_norm(x, pre_mix_norm[i])
        proj = hn @ w_in[i]
        qa, ka, va, gb, gc, hb, qc, kc, vc = jnp.split(proj, IN_SPLITS, axis=-1)
        oa = dilated_mixer(qa.reshape(b, s, A_HEADS, HEAD_DIM), ka.reshape(b, s, A_HEADS, HEAD_DIM),
                           va.reshape(b, s, A_HEADS, HEAD_DIM), rel_bias)
        ob = short_conv_mixer(gb, gc, hb, conv_w[i])
        oc = axial_gqa_mixer(qc.reshape(b, s, C_HEADS, HEAD_DIM), kc.reshape(b, s, C_KV_HEADS, HEAD_DIM),
                             vc.reshape(b, s, C_KV_HEADS, HEAD_DIM), q_norm[i], k_norm[i])
        mix = jnp.concatenate([rms_norm(oa, out_norm_a[i]), rms_norm(ob, out_norm_b[i]),
                               rms_norm(oc, out_norm_c[i])], axis=-1)
        x = x + rms_norm(mix @ w_out[i], post_mix_norm[i])
        hn = rms_norm(x, pre_mlp_norm[i])
        ff = jnp.square(jax.nn.relu(hn @ w_up[i])) @ w_down[i]
        x = x + rms_norm(ff, post_mlp_norm[i])
    return x
```

```cpp
#include <hip/hip_runtime.h>
#include <cstdio>
#include <cstdint>
namespace pg8 {
#define PG8_LAS __attribute__((address_space(3)))
typedef unsigned short bf16_t;
typedef short bf16x8 __attribute__((ext_vector_type(8)));
typedef float f32x4 __attribute__((ext_vector_type(4)));
typedef unsigned u32x4 __attribute__((ext_vector_type(4)));
constexpr int BM = 256, BK = 64, HALF = 128, HTB = HALF * BK * 2  , STAGE_BYTES = 8 * HTB, NXCD = 8, WGM = 8;

__host__ __device__ __forceinline__ int lds_byte(int r, int c) { const int st = (r >> 4) * 2 + (c >> 5), rr = r & 15, cc = c & 31, ob = rr * 64 + cc * 2; return st * 1024 + (ob ^ (((ob >> 9) & 1) << 5)); }
__host__ __device__ __forceinline__ void stage_rc(int b, int& R, int& C) { const int st = b / 1024, sb = b % 1024, swz = sb ^ (((sb >> 9) & 1) << 5); R = (st >> 1) * 16 + swz / 64; C = (st & 1) * 32 + (swz % 64) / 2; }
__host__ __device__ __forceinline__ int perm32(int rho) { const int n = rho >> 4, i = rho & 15; return 8 * (i >> 2) + 4 * n + (i & 3); }

struct Unit { int pm, pn; };
struct Gemm { const bf16_t* A; const bf16_t* Bt; int M, N, K; };

struct StaticOrder {
    int nM, nN, nwg, G, c, wgm;
    __host__ __device__ void init(int M, int N, int G_, int c_, int wgm_ = WGM) { nM = M / BM; nN = N / BM; nwg = nM * nN; G = G_; c = c_; wgm = wgm_; }
    __host__ __device__ bool next(int i, Unit& u) const {
        const long L = (long)i * G + c; if (L >= nwg) return false;
        int wgid = (int)L; { const int q = nwg / NXCD, r = nwg % NXCD, xcd = wgid % NXCD, off = wgid / NXCD; wgid = (xcd < r ? xcd * (q + 1) : r * (q + 1) + (xcd - r) * q) + off; }
        const int nig = wgm * nN, gid = wgid / nig, fm = gid * wgm, gsz = (nM - fm) < wgm ? (nM - fm) : wgm;
        u.pm = fm + ((wgid % nig) % gsz); u.pn = (wgid % nig) / gsz; return true;
    }
    __device__ __forceinline__ void a_ready(const Unit&) const {}
    __device__ __forceinline__ void done(const Unit&) const {}
};

__device__ __forceinline__ unsigned cvt_pk_bf16(float lo, float hi) { unsigned r; asm volatile("v_cvt_pk_bf16_f32 %0, %1, %2" : "=v"(r) : "v"(lo), "v"(hi)); return r; }
typedef float f32x2 __attribute__((ext_vector_type(2)));
typedef int i32x4 __attribute__((ext_vector_type(4)));
template <bool I8> struct MT;
template <> struct MT<false> { typedef bf16x8 frag; typedef f32x4 acc;
    static __device__ __forceinline__ acc mma(frag a, frag b, acc c) { return __builtin_amdgcn_mfma_f32_16x16x32_bf16(a, b, c, 0, 0, 0); }
    static __device__ __forceinline__ acc zero() { return (f32x4){0.f, 0.f, 0.f, 0.f}; } };
template <> struct MT<true> { typedef i32x4 frag; typedef i32x4 acc;
    static __device__ __forceinline__ acc mma(frag a, frag b, acc c) { return __builtin_amdgcn_mfma_i32_16x16x64_i8(a, b, c, 0, 0, 0); }
    static __device__ __forceinline__ acc zero() { return (i32x4){0, 0, 0, 0}; } };
template <int ACT, bool TILED = false> struct EpiBf16 {
    static constexpr bool PERM = true, AFTER_DRAIN = false;
    bf16_t* O; int ldc; const float* rs;
    __device__ __forceinline__ void operator()(const f32x4 (&acc)[2][2][4][2], const Unit& u, int wr, int wc, int fr, int fq) const {
        const int row0 = u.pm * BM + wr * 64 + fr, col0 = u.pn * BM + wc * 32 + 8 * fq;
#pragma unroll
        for (int ai = 0; ai < 2; ++ai)
#pragma unroll
            for (int m = 0; m < 4; ++m) { const int row = row0 + ai * HALF + m * 16;
                bf16_t* rowp = TILED ? O + ((((size_t)u.pm * (ldc >> 6) + (u.pn * 4 + (wc >> 1))) * 256 + (wr * 64 + fr + ai * HALF + m * 16)) * 64 + (wc & 1) * 32 + 8 * fq)
                                     : O + (size_t)row * ldc + col0;
                const float sc = rs ? rs[row] : 1.0f;
#pragma unroll
                for (int bj = 0; bj < 2; ++bj) { f32x4 v0 = acc[ai][bj][m][0] * sc, v1 = acc[ai][bj][m][1] * sc;
                    if (ACT == 2) {
#pragma unroll
                        for (int e = 0; e < 4; ++e) { const float a = fmaxf(v0[e], 0.f), b = fmaxf(v1[e], 0.f); v0[e] = a * a; v1[e] = b * b; } }
                    u32x4 w; w.x = cvt_pk_bf16(v0[0], v0[1]); w.y = cvt_pk_bf16(v0[2], v0[3]); w.z = cvt_pk_bf16(v1[0], v1[1]); w.w = cvt_pk_bf16(v1[2], v1[3]);
                    *(u32x4*)(rowp + (TILED ? bj * 2 * 256 * 64 : bj * HALF)) = w; } }
    }
};
struct EpiF32 {
    static constexpr bool PERM = false, AFTER_DRAIN = false;
    float* C; int ldc;
    __device__ __forceinline__ void operator()(const f32x4 (&acc)[2][2][4][2], const Unit& u, int wr, int wc, int fr, int fq) const {
        const int row0 = u.pm * BM + wr * 64 + fr, col0 = u.pn * BM + wc * 32 + 4 * fq;
#pragma unroll
        for (int ai = 0; ai < 2; ++ai)
#pragma unroll
            for (int m = 0; m < 4; ++m) { float* rowp = C + (size_t)(row0 + ai * HALF + m * 16) * ldc + col0;
#pragma unroll
                for (int bj = 0; bj < 2; ++bj)
#pragma unroll
                    for (int n = 0; n < 2; ++n) *(f32x4*)(rowp + bj * HALF + n * 16) = acc[ai][bj][m][n]; }
    }
};
struct EpiI8H {
    static constexpr bool PERM = true, AFTER_DRAIN = false;
    bf16_t* O; int ldc; const unsigned* cmax; unsigned* rmax;
    __device__ __forceinline__ void operator()(const i32x4 (&acc)[2][2][4][2], const Unit& u, int wr, int wc, int fr, int fq) const {
        asm volatile("" : "+v"(fr));
        const int col0 = u.pn * BM + wc * 32 + 8 * fq, lane = fr + 16 * fq;
        float cs[2][8];
#pragma unroll
        for (int bj = 0; bj < 2; ++bj) { const u32x4 cb0 = *(const u32x4*)(cmax + col0 + bj * HALF), cb1 = *(const u32x4*)(cmax + col0 + bj * HALF + 4);
#pragma unroll
            for (int e = 0; e < 4; ++e) { cs[bj][e] = __uint_as_float(cb0[e]) * (1.0f / 127.0f); cs[bj][4 + e] = __uint_as_float(cb1[e]) * (1.0f / 127.0f); } }
#pragma unroll
        for (int ai = 0; ai < 2; ++ai)
#pragma unroll
            for (int m = 0; m < 4; ++m) { const int rl = wr * 64 + fr + ai * HALF + m * 16;
                bf16_t* rowp = O + ((((size_t)u.pm * (ldc >> 6) + (u.pn * 4 + (wc >> 1))) * 256 + rl) * 64 + (wc & 1) * 32 + 8 * fq);
                float tm = 0.f;
#pragma unroll
                for (int bj = 0; bj < 2; ++bj) { float v[8];
#pragma unroll
                    for (int e = 0; e < 4; ++e) { const float a = fmaxf((float)acc[ai][bj][m][0][e] * cs[bj][e], 0.f), b = fmaxf((float)acc[ai][bj][m][1][e] * cs[bj][4 + e], 0.f);
                        tm = fmaxf(tm, fmaxf(a, b)); v[e] = a * a; v[4 + e] = b * b; }
                    u32x4 w; w.x = cvt_pk_bf16(v[0], v[1]); w.y = cvt_pk_bf16(v[2], v[3]); w.z = cvt_pk_bf16(v[4], v[5]); w.w = cvt_pk_bf16(v[6], v[7]);
                    *(u32x4*)(rowp + bj * 2 * 256 * 64) = w; }
                if (rmax) {
                    tm = fmaxf(tm, __int_as_float(__builtin_amdgcn_ds_bpermute((lane ^ 16) << 2, __float_as_int(tm))));
                    tm = fmaxf(tm, __int_as_float(__builtin_amdgcn_ds_bpermute((lane ^ 32) << 2, __float_as_int(tm))));
                    if (fq == 0) (void)__hip_atomic_fetch_max(rmax + u.pm * BM + rl, __float_as_uint(tm), __ATOMIC_RELAXED, __HIP_MEMORY_SCOPE_AGENT); } }
    }
};
struct EpiI8D {
    static constexpr bool PERM = true, AFTER_DRAIN = false;
    bf16_t* O; int ldc; const unsigned* cmax; const int* csum;
    __device__ __forceinline__ void operator()(const i32x4 (&acc)[2][2][4][2], const Unit& u, int wr, int wc, int fr, int fq) const {
        const int row0 = u.pm * BM + wr * 64 + fr, col0 = u.pn * BM + wc * 32 + 8 * fq;
#pragma unroll
        for (int bj = 0; bj < 2; ++bj) {
            const u32x4 cb0 = *(const u32x4*)(cmax + col0 + bj * HALF), cb1 = *(const u32x4*)(cmax + col0 + bj * HALF + 4);
            const i32x4 k0 = *(const i32x4*)(csum + col0 + bj * HALF) * 128, k1 = *(const i32x4*)(csum + col0 + bj * HALF + 4) * 128;
#pragma unroll
            for (int ai = 0; ai < 2; ++ai)
#pragma unroll
                for (int m = 0; m < 4; ++m) { const int row = row0 + ai * HALF + m * 16; float v[8];
#pragma unroll
                    for (int e = 0; e < 4; ++e) { v[e] = (float)(acc[ai][bj][m][0][e] + k0[e]) * (__uint_as_float(cb0[e]) * (1.0f / 127.0f)); v[4 + e] = (float)(acc[ai][bj][m][1][e] + k1[e]) * (__uint_as_float(cb1[e]) * (1.0f / 127.0f)); }
                    u32x4 w; w.x = cvt_pk_bf16(v[0], v[1]); w.y = cvt_pk_bf16(v[2], v[3]); w.z = cvt_pk_bf16(v[4], v[5]); w.w = cvt_pk_bf16(v[6], v[7]);
                    *(u32x4*)(O + (size_t)row * ldc + col0 + bj * HALF) = w; } }
    }
};
struct EpiI8P {
    static constexpr bool PERM = true, AFTER_DRAIN = false;
    bf16_t* O; int ldc; const float* rf; const unsigned* cmax;
    __device__ __forceinline__ void operator()(const i32x4 (&acc)[2][2][4][2], const Unit& u, int wr, int wc, int fr, int fq) const {
        const int row0 = u.pm * BM + wr * 64 + fr, col0 = u.pn * BM + wc * 32 + 8 * fq;
#pragma unroll
        for (int ai = 0; ai < 2; ++ai)
#pragma unroll
            for (int m = 0; m < 4; ++m) { const int row = row0 + ai * HALF + m * 16; const float sc = rf[row] * (1.0f / 127.0f);
#pragma unroll
                for (int bj = 0; bj < 2; ++bj) {
                    const u32x4 cb0 = *(const u32x4*)(cmax + col0 + bj * HALF), cb1 = *(const u32x4*)(cmax + col0 + bj * HALF + 4);
                    float v[8];
#pragma unroll
                    for (int e = 0; e < 4; ++e) { v[e] = (float)acc[ai][bj][m][0][e] * sc * __uint_as_float(cb0[e]); v[4 + e] = (float)acc[ai][bj][m][1][e] * sc * __uint_as_float(cb1[e]); }
                    u32x4 w; w.x = cvt_pk_bf16(v[0], v[1]); w.y = cvt_pk_bf16(v[2], v[3]); w.z = cvt_pk_bf16(v[4], v[5]); w.w = cvt_pk_bf16(v[6], v[7]);
                    *(u32x4*)(O + (size_t)row * ldc + col0 + bj * HALF) = w; } }
    }
};

template <class Epi, class Sched, bool ALIGN_EPI = false, bool SP2 = false, bool TILED_A = false, bool TILED_B = false, bool I8 = false>
__device__ __forceinline__ void gemm_phase(PG8_LAS unsigned char* lds, const Gemm g, const Sched& S, const Epi& E) {
    int tid_ = threadIdx.x; asm volatile("" : "+v"(tid_));
    const int tid = tid_, wid = __builtin_amdgcn_readfirstlane(tid >> 6), lane = tid & 63, wr = wid >> 2, wc = wid & 3, fr = lane & 15, fq = lane >> 4;
    const int K = g.K, nt = K / BK;
    unsigned voffA[2], voffB[2];
#pragma unroll
    for (int i = 0; i < 2; ++i) { int R, C; stage_rc(tid * 16 + i * 8192, R, C); const int Rb = Epi::PERM ? ((R & ~31) + perm32(R & 31)) : R;
        voffA[i] = (unsigned)(R * (TILED_A ? BK : K) + C) * 2u; voffB[i] = (unsigned)(Rb * (TILED_B ? BK : K) + C) * 2u; }
    const size_t kstepA = TILED_A ? (size_t)(BM * BK * 2) : (size_t)(BK * 2), kstepB = TILED_B ? (size_t)(BM * BK * 2) : (size_t)(BK * 2);
    const size_t hstepA = TILED_A ? (size_t)(HALF * BK * 2) : (size_t)HALF * K * 2, hstepB = TILED_B ? (size_t)(HALF * BK * 2) : (size_t)HALF * K * 2;
    const size_t tstep = (size_t)BM * K * 2;
    const unsigned ldsw = (unsigned)wid * 1024u;
    const int aoff = lds_byte(wr * 64 + fr, fq * 8), boff = lds_byte(wc * 32 + fr, fq * 8);
#define PG8_SA(b, h) (((b) * 2 + (h)) * HTB)
#define PG8_SB(b, h) ((4 + (b) * 2 + (h)) * HTB)
#define PG8_STAGE(bufoff, gbase, voff) do { _Pragma("unroll") for (int _i = 0; _i < 2; ++_i) \
        __builtin_amdgcn_global_load_lds((const unsigned*)((const char*)(gbase) + (voff)[_i]), (PG8_LAS unsigned*)(lds + (bufoff) + ldsw + _i * 8192), 16, 0, 0); } while (0)
#define PG8_LDA(dst, b, h) do { _Pragma("unroll") for (int m = 0; m < 4; ++m) _Pragma("unroll") for (int k = 0; k < 2; ++k) dst[m][k] = *(const PG8_LAS frag_t*)(lds + PG8_SA(b, h) + aoff + m * 2048 + k * 1024); } while (0)
#define PG8_LDB(dst, b, h) do { _Pragma("unroll") for (int n = 0; n < 2; ++n) _Pragma("unroll") for (int k = 0; k < 2; ++k) dst[n][k] = *(const PG8_LAS frag_t*)(lds + PG8_SB(b, h) + boff + n * 2048 + k * 1024); } while (0)
#define PG8_MMA(ai, bj, At, Bt) do { __builtin_amdgcn_s_setprio(1); _Pragma("unroll") for (int m = 0; m < 4; ++m) _Pragma("unroll") for (int n = 0; n < 2; ++n) _Pragma("unroll") for (int k = 0; k < 2; ++k) \
        acc[ai][bj][m][n] = MT<I8>::mma(Bt[n][k], At[m][k], acc[ai][bj][m][n]); __builtin_amdgcn_s_setprio(0); } while (0)
#define PG8_WAIT_V(n) asm volatile("s_waitcnt vmcnt(" #n ")" ::: "memory")
#define PG8_WAIT_L(n) asm volatile("s_waitcnt lgkmcnt(" #n ")" ::: "memory")
#define PG8_BAR __builtin_amdgcn_s_barrier()
#define PG8_SCHED __builtin_amdgcn_sched_barrier(0)
    Unit cur, nxt; int ui = 0;
    if (!S.next(0, cur)) return;
    typedef typename MT<I8>::frag frag_t; typedef typename MT<I8>::acc acc_t;
    acc_t acc[2][2][4][2];
#pragma unroll
    for (int a = 0; a < 2; ++a)
#pragma unroll
        for (int b = 0; b < 2; ++b)
#pragma unroll
            for (int m = 0; m < 4; ++m)
#pragma unroll
                for (int n = 0; n < 2; ++n) acc[a][b][m][n] = MT<I8>::zero();
    frag_t At[4][2], B0[2][2], B1[2][2];
    const char* cA = (const char*)g.A + (size_t)cur.pm * tstep; const char* cB = (const char*)g.Bt + (size_t)cur.pn * tstep;
    S.a_ready(cur);
    if constexpr (SP2) {
        PG8_STAGE(PG8_SB(0, 0), cB, voffB); PG8_STAGE(PG8_SB(0, 1), cB + hstepB, voffB); PG8_STAGE(PG8_SA(0, 0), cA, voffA); PG8_STAGE(PG8_SA(0, 1), cA + hstepA, voffA);
        if (wr == 1) PG8_BAR;
        PG8_WAIT_V(2); PG8_BAR;
        PG8_STAGE(PG8_SB(1, 0), cB + kstepB, voffB); PG8_STAGE(PG8_SA(1, 0), cA + kstepA, voffA); PG8_STAGE(PG8_SB(1, 1), cB + hstepB + kstepB, voffB);
        PG8_WAIT_V(6); PG8_BAR;
    } else {
        PG8_STAGE(PG8_SB(0, 0), cB, voffB); PG8_STAGE(PG8_SA(0, 0), cA, voffA); PG8_STAGE(PG8_SB(0, 1), cB + hstepB, voffB); PG8_STAGE(PG8_SA(0, 1), cA + hstepA, voffA);
        if (wr == 1) PG8_BAR;
        PG8_WAIT_V(4); PG8_BAR;
        PG8_STAGE(PG8_SB(1, 0), cB + kstepB, voffB); PG8_STAGE(PG8_SA(1, 0), cA + kstepA, voffA); PG8_STAGE(PG8_SB(1, 1), cB + hstepB + kstepB, voffB);
        PG8_WAIT_V(6); PG8_BAR;
    }
    for (;;) {
        const bool has_next = S.next(ui + 1, nxt);
        const char* nA = has_next ? (const char*)g.A + (size_t)nxt.pm * tstep : cA; const char* nB = has_next ? (const char*)g.Bt + (size_t)nxt.pn * tstep : cB;
        for (int t = 0; t < nt; t += 2) {
            const bool last = (t == nt - 2);
            const char* a1 = cA + (size_t)(t + 1) * kstepA;
            const char* a2 = last ? nA : cA + (size_t)(t + 2) * kstepA; const char* b2 = last ? nB : cB + (size_t)(t + 2) * kstepB;
            const char* a3 = a2 + kstepA; const char* b3 = b2 + kstepB;
            if (last && has_next) S.a_ready(nxt);
            if constexpr (SP2) {
            PG8_LDB(B0, 0, 0); PG8_LDB(B1, 0, 1); PG8_SCHED; PG8_LDA(At, 0, 0); PG8_STAGE(PG8_SA(1, 1), a1 + hstepA, voffA);
            PG8_WAIT_V(8); PG8_WAIT_L(0); PG8_BAR; PG8_MMA(0, 0, At, B0); PG8_MMA(0, 1, At, B1); PG8_BAR; PG8_SCHED;
            PG8_LDA(At, 0, 1); PG8_STAGE(PG8_SB(0, 0), b2, voffB); PG8_STAGE(PG8_SB(0, 1), b2 + hstepB, voffB); PG8_STAGE(PG8_SA(0, 0), a2, voffA);
            PG8_WAIT_V(8); PG8_WAIT_L(0); PG8_BAR; PG8_MMA(1, 0, At, B0); PG8_MMA(1, 1, At, B1); PG8_BAR; PG8_SCHED;
            PG8_LDB(B0, 1, 0); PG8_LDB(B1, 1, 1); PG8_SCHED; PG8_LDA(At, 1, 0); PG8_STAGE(PG8_SA(0, 1), a2 + hstepA, voffA);
            PG8_WAIT_V(8); PG8_WAIT_L(0); PG8_BAR; PG8_MMA(0, 0, At, B0); PG8_MMA(0, 1, At, B1); PG8_BAR; PG8_SCHED;
            PG8_LDA(At, 1, 1); PG8_STAGE(PG8_SB(1, 0), b3, voffB); PG8_STAGE(PG8_SB(1, 1), b3 + hstepB, voffB); PG8_STAGE(PG8_SA(1, 0), a3, voffA);
            PG8_WAIT_V(8); PG8_WAIT_L(0); PG8_BAR; PG8_MMA(1, 0, At, B0); PG8_MMA(1, 1, At, B1); PG8_BAR; PG8_SCHED;
            } else {
            PG8_LDB(B0, 0, 0); PG8_SCHED; PG8_LDA(At, 0, 0); PG8_STAGE(PG8_SA(1, 1), a1 + hstepA, voffA);
            PG8_WAIT_L(8); PG8_BAR; PG8_WAIT_L(0); PG8_MMA(0, 0, At, B0); PG8_BAR; PG8_SCHED;
            PG8_LDB(B1, 0, 1); PG8_STAGE(PG8_SB(0, 0), b2, voffB);
            PG8_BAR; PG8_WAIT_L(0); PG8_MMA(0, 1, At, B1); PG8_BAR;
            PG8_LDA(At, 0, 1); PG8_STAGE(PG8_SA(0, 0), a2, voffA);
            PG8_BAR; PG8_WAIT_L(0); PG8_MMA(1, 0, At, B0); PG8_BAR; PG8_SCHED;
            PG8_STAGE(PG8_SB(0, 1), b2 + hstepB, voffB);
            PG8_WAIT_V(6); PG8_BAR; PG8_MMA(1, 1, At, B1); PG8_BAR;
            PG8_LDB(B0, 1, 0); PG8_SCHED; PG8_LDA(At, 1, 0); PG8_STAGE(PG8_SA(0, 1), a2 + hstepA, voffA);
            PG8_WAIT_L(8); PG8_BAR; PG8_WAIT_L(0); PG8_MMA(0, 0, At, B0); PG8_BAR; PG8_SCHED;
            PG8_LDB(B1, 1, 1); PG8_STAGE(PG8_SB(1, 0), b3, voffB);
            PG8_BAR; PG8_WAIT_L(0); PG8_MMA(0, 1, At, B1); PG8_BAR;
            PG8_LDA(At, 1, 1); PG8_STAGE(PG8_SA(1, 0), a3, voffA);
            PG8_BAR; PG8_WAIT_L(0); PG8_MMA(1, 0, At, B0); PG8_BAR; PG8_SCHED;
            PG8_STAGE(PG8_SB(1, 1), b3 + hstepB, voffB);
            PG8_WAIT_V(6); PG8_BAR; PG8_MMA(1, 1, At, B1); PG8_BAR;
            }
        }
        if constexpr (ALIGN_EPI) { if (wr == 0) PG8_BAR; }
        if constexpr (!Epi::AFTER_DRAIN) { E(acc, cur, wr, wc, fr, fq); S.done(cur); }
        if (!has_next) break;
#pragma unroll
        for (int a = 0; a < 2; ++a)
#pragma unroll
            for (int b = 0; b < 2; ++b)
#pragma unroll
                for (int m = 0; m < 4; ++m)
#pragma unroll
                    for (int n = 0; n < 2; ++n) acc[a][b][m][n] = MT<I8>::zero();
        cur = nxt; cA = nA; cB = nB; ++ui;
        if constexpr (ALIGN_EPI) { if (wr == 1) PG8_BAR; }
    }
    PG8_WAIT_V(0);
    if constexpr (!ALIGN_EPI) { if (wr == 0) PG8_BAR; }
    PG8_BAR;
    if constexpr (Epi::AFTER_DRAIN) { E.fused(acc, cur, wr, wc, fr, fq, lds, wid, lane); S.done(cur); }
#undef PG8_SA
#undef PG8_SB
#undef PG8_STAGE
#undef PG8_LDA
#undef PG8_LDB
#undef PG8_MMA
#undef PG8_WAIT_V
#undef PG8_WAIT_L
#undef PG8_BAR
#undef PG8_SCHED
}
}
namespace att {
typedef unsigned short bf16_t;
using bf16x8 = __attribute__((ext_vector_type(8))) short;
using s16x4  = __attribute__((ext_vector_type(4))) short;
using f32x16 = __attribute__((ext_vector_type(16))) float;
using u32x4  = __attribute__((ext_vector_type(4))) unsigned;
typedef float f32x2a __attribute__((ext_vector_type(2)));
typedef float f32x4a __attribute__((ext_vector_type(4)));
constexpr int   D = 128, NW = 8, QBLK = 32, KVBLK = 64;
constexpr float SCALE = 0.088388347648318440f;
constexpr float THR = 8.f;
constexpr int SEQ = 8192, INW = 9216;
constexpr int LDQ = INW, LDKK = 512, LDV = INW, LDO = 2048;
constexpr size_t SHM_V = KVBLK * D * 2, SHM_K = KVBLK * D * 2, SHM_ATTN = 2 * SHM_V + 2 * SHM_K + NW * 64 * 4;
#define KSWZ(row, colB) ((row) * 256 + ((colB) ^ (((row) & 7) << 4)))
#define SBAR() __builtin_amdgcn_sched_barrier(0)
__device__ __forceinline__ int crow(int r, int hi) { return (r & 3) + 8 * (r >> 2) + 4 * hi; }
typedef float f32x2_t __attribute__((ext_vector_type(2))); typedef __bf16 bf16x2_t __attribute__((ext_vector_type(2)));
__device__ __forceinline__ unsigned cvtpk(float lo, float hi) { f32x2_t v = {lo, hi}; bf16x2_t b = __builtin_convertvector(v, bf16x2_t); return __builtin_bit_cast(unsigned, b); }
__device__ __forceinline__ float bf2f(short v) { return __uint_as_float(((unsigned)(unsigned short)v) << 16); }
__device__ __forceinline__ bf16x8 ld8(const bf16_t* p) { return *reinterpret_cast<const bf16x8*>(p); }

__device__ __forceinline__ void partialSM(f32x16& p0, f32x16& p1, float& m_reg, float& mn, float& alpha) {
  constexpr float C = SCALE * 1.4426950408889634f;
  float pmax = p0[0]; for (int r = 1; r < 16; ++r) pmax = fmaxf(pmax, p0[r]); for (int r = 0; r < 16; ++r) pmax = fmaxf(pmax, p1[r]);
  { auto rr = __builtin_amdgcn_permlane32_swap(__float_as_uint(pmax), __float_as_uint(pmax), false, false);
    pmax = fmaxf(__uint_as_float(rr[0]), __uint_as_float(rr[1])); }
  if (__builtin_expect(__all(pmax - m_reg <= THR / SCALE), 1)) { mn = m_reg; alpha = 1.f; }
  else { mn = fmaxf(m_reg, pmax); alpha = __builtin_amdgcn_exp2f((m_reg - mn) * C); m_reg = mn; }
  float mnC = -mn * C;
  for (int r = 0; r < 16; ++r) p0[r] = fmaf(p0[r], C, mnC); for (int r = 0; r < 16; ++r) p1[r] = fmaf(p1[r], C, mnC);
  for (int r = 0; r < 16; ++r) p0[r] = __builtin_amdgcn_exp2f(p0[r]);
}
#define ATT_PK4(P, BASE, OUT) do { unsigned a0 = cvtpk(P[BASE + 0], P[BASE + 1]), a1 = cvtpk(P[BASE + 2], P[BASE + 3]);   \
    unsigned b0 = cvtpk(P[BASE + 4], P[BASE + 5]), b1 = cvtpk(P[BASE + 6], P[BASE + 7]);                              \
    auto r0 = __builtin_amdgcn_permlane32_swap(a0, b0, false, false); auto r1 = __builtin_amdgcn_permlane32_swap(a1, b1, false, false); \
    u32x4 w = {r0[0], r1[0], r0[1], r1[1]}; OUT = *reinterpret_cast<bf16x8*>(&w); } while (0)
__device__ __forceinline__ void finishSM(f32x16& p0, f32x16& p1, float alpha, float& l_reg, bf16x8& pa0, bf16x8& pa1, bf16x8& pa2, bf16x8& pa3) {
  for (int r = 0; r < 16; ++r) p1[r] = __builtin_amdgcn_exp2f(p1[r]);
  float ps = 0; for (int r = 0; r < 16; ++r) ps += p0[r]; for (int r = 0; r < 16; ++r) ps += p1[r];
  { auto rr = __builtin_amdgcn_permlane32_swap(__float_as_uint(ps), __float_as_uint(ps), false, false);
    ps = __uint_as_float(rr[0]) + __uint_as_float(rr[1]); }
  l_reg = l_reg * alpha + ps;
  ATT_PK4(p0, 0, pa0); ATT_PK4(p0, 8, pa1); ATT_PK4(p1, 0, pa2); ATT_PK4(p1, 8, pa3);
}
__device__ __forceinline__ void qkt(f32x16& p0, f32x16& p1, const bf16_t* Ks, const bf16x8* qr, int r32, int hi) {
  p0 = f32x16{}; p1 = f32x16{};
  for (int d0 = 0; d0 < 8; ++d0) { int cb = (d0 * 16 + hi * 8) * 2;
    bf16x8 b0 = *reinterpret_cast<const bf16x8*>((const char*)Ks + KSWZ(r32, cb));
    bf16x8 b1 = *reinterpret_cast<const bf16x8*>((const char*)Ks + KSWZ(32 + r32, cb));
    p0 = __builtin_amdgcn_mfma_f32_32x32x16_bf16(b0, qr[d0], p0, 0, 0, 0);
    p1 = __builtin_amdgcn_mfma_f32_32x32x16_bf16(b1, qr[d0], p1, 0, 0, 0); }
}
__device__ __forceinline__ int v_st(int k, int c) { const int kk = (k & ~0xC) | ((k & 4) << 1) | ((k & 8) >> 1); return ((kk >> 3) * 4 + (c >> 5)) * 512 + ((kk & 7) * 32 + (c & 31)) * 2; }
__device__ __forceinline__ int v_rd_base(int lane) { return ((lane & 3) << 3) | (((lane >> 2) & 3) << 6) | (((lane >> 4) & 1) << 5) | (((lane >> 5) & 1) << 8); }
constexpr int v_rd_off(int d0, int ks, int half) { return d0 * 512 + ks * 4096 + half * 2048; }
template <int OFF> __device__ __forceinline__ s16x4 tr_read(int vb) {
  s16x4 r; asm volatile("ds_read_b64_tr_b16 %0, %1 offset:%2" : "=&v"(r) : "v"(vb), "i"(OFF) : "memory"); return r;
}
#define ATT_PK(L, H) (bf16x8){L[0], L[1], L[2], L[3], H[0], H[1], H[2], H[3]}
template <int D0> __device__ __forceinline__ void pv_one(f32x16& od, int vb, bf16x8 pa0, bf16x8 pa1, bf16x8 pa2, bf16x8 pa3) {
  const s16x4 l0 = tr_read<v_rd_off(D0, 0, 0)>(vb), h0 = tr_read<v_rd_off(D0, 0, 1)>(vb), l1 = tr_read<v_rd_off(D0, 1, 0)>(vb), h1 = tr_read<v_rd_off(D0, 1, 1)>(vb);
  const s16x4 l2 = tr_read<v_rd_off(D0, 2, 0)>(vb), h2 = tr_read<v_rd_off(D0, 2, 1)>(vb), l3 = tr_read<v_rd_off(D0, 3, 0)>(vb), h3 = tr_read<v_rd_off(D0, 3, 1)>(vb);
  asm volatile("s_waitcnt lgkmcnt(0)" ::: "memory"); SBAR();
  od = __builtin_amdgcn_mfma_f32_32x32x16_bf16(pa0, ATT_PK(l0, h0), od, 0, 0, 0);
  od = __builtin_amdgcn_mfma_f32_32x32x16_bf16(pa1, ATT_PK(l1, h1), od, 0, 0, 0);
  od = __builtin_amdgcn_mfma_f32_32x32x16_bf16(pa2, ATT_PK(l2, h2), od, 0, 0, 0);
  od = __builtin_amdgcn_mfma_f32_32x32x16_bf16(pa3, ATT_PK(l3, h3), od, 0, 0, 0);
}
__device__ __forceinline__ void pv_d0(f32x16* o, int vb, bf16x8 pa0, bf16x8 pa1, bf16x8 pa2, bf16x8 pa3) {
  pv_one<0>(o[0], vb, pa0, pa1, pa2, pa3); pv_one<1>(o[1], vb, pa0, pa1, pa2, pa3); pv_one<2>(o[2], vb, pa0, pa1, pa2, pa3); pv_one<3>(o[3], vb, pa0, pa1, pa2, pa3);
}

template <bool FAST> __device__ __forceinline__ void psm(f32x16& p0, f32x16& p1, float& m_reg, float& mn, float& alpha) {
  if constexpr (FAST) { alpha = 1.f; for (int r = 0; r < 16; ++r) p0[r] = __builtin_amdgcn_exp2f(p0[r]); }
  else partialSM(p0, p1, m_reg, mn, alpha);
}
template <bool FAST> __device__ __forceinline__ void fsm(f32x16& p0, f32x16& p1, float alpha, float& l_reg, bf16x8& pa0, bf16x8& pa1, bf16x8& pa2, bf16x8& pa3) {
  if constexpr (FAST) finishSM(p0, p1, 1.f, l_reg, pa0, pa1, pa2, pa3); else finishSM(p0, p1, alpha, l_reg, pa0, pa1, pa2, pa3);
}
template <bool FAST> __device__ __forceinline__ void attn_dense_body(const bf16_t* __restrict__ Qb, const bf16_t* __restrict__ Kh, const bf16_t* __restrict__ Vh,
                                                bf16_t* __restrict__ Ob, int t0, const float* __restrict__ qg, const f32x2a* __restrict__ rtab, char* lds) {
  int tid_ = threadIdx.x; asm volatile("" : "+v"(tid_));
  const int tid = tid_, wid = __builtin_amdgcn_readfirstlane(tid >> 6), lane = tid & 63, r32 = lane & 31, hi = lane >> 5;
  bf16_t* V_lds = (bf16_t*)lds; bf16_t* K_lds = (bf16_t*)(lds + 2 * SHM_V);
  float* ws = (float*)(lds + 2 * SHM_V + 2 * SHM_K) + wid * 64; float* li_l = ws; float* al_l = ws + 32;
  float m_reg = -1e30f, l_reg = 0; f32x16 o[4] = {}; bf16x8 qr[8];
  {
    const int prow = tid >> 4, chunk = tid & 15, i0 = (chunk & 3) * 8; const bool second = (chunk & 4) != 0;
    float gq[8];
#pragma unroll
    for (int e = 0; e < 8; ++e) gq[e] = qg[chunk * 8 + e];
#pragma unroll 2
    for (int p = 0; p < 8; ++p) { const int row = p * 32 + prow;
      const bf16x8 raw = ld8(Qb + (long)row * LDQ + chunk * 8);
      float v[8]; float ss = 0.f;
#pragma unroll
      for (int e = 0; e < 8; ++e) { v[e] = bf2f(raw[e]); ss += v[e] * v[e]; }
      ss += __shfl_xor(ss, 1); ss += __shfl_xor(ss, 2); ss += __shfl_xor(ss, 4); ss += __shfl_xor(ss, 8);
      const float rstd = (FAST ? SCALE * 1.4426950408889634f : 1.0f) / sqrtf(ss * (1.0f / 128.0f) + 1e-6f);
      const int t = t0 + row, pos = (chunk < 8) ? (t >> 6) : (t & 63);
      float o8[8];
#pragma unroll
      for (int e = 0; e < 8; ++e) v[e] *= rstd * gq[e];
#pragma unroll
      for (int e = 0; e < 8; ++e) { const float pr = __shfl_xor(v[e], 4); const f32x2a cs = rtab[pos * 32 + i0 + e];
        o8[e] = second ? (v[e] * cs.x + pr * cs.y) : (v[e] * cs.x - pr * cs.y); }
      u32x4 w = {cvtpk(o8[0], o8[1]), cvtpk(o8[2], o8[3]), cvtpk(o8[4], o8[5]), cvtpk(o8[6], o8[7])};
      *(u32x4*)(lds + KSWZ(row, chunk * 16)) = w; }
    __syncthreads();
#pragma unroll
    for (int d0 = 0; d0 < 8; ++d0) qr[d0] = *reinterpret_cast<const bf16x8*>(lds + KSWZ(wid * QBLK + r32, (d0 * 16 + hi * 8) * 2));
    __syncthreads();
  }
  const int sr = tid >> 4, sc = (tid & 15) * 8, vst0 = v_st(sr, sc), vst1 = v_st(32 + sr, sc);
  const int vb0 = (int)(uintptr_t)V_lds + v_rd_base(lane);
  struct { bf16x8 vs0, vs1, ks0, ks1; } sr_[2];
  const unsigned voff = (unsigned)(sr * LDV + sc) * 2u, koff = (unsigned)(sr * LDKK + sc) * 2u;
#define SLOAD(i, k0) do { const char* vb_ = (const char*)Vh + (size_t)(k0) * (LDV * 2); const char* kb_ = (const char*)Kh + (size_t)(k0) * (LDKK * 2); \
    sr_[i].vs0 = *(const bf16x8*)(vb_ + voff); sr_[i].vs1 = *(const bf16x8*)(vb_ + 32 * LDV * 2 + voff); \
    sr_[i].ks0 = *(const bf16x8*)(kb_ + koff); sr_[i].ks1 = *(const bf16x8*)(kb_ + 32 * LDKK * 2 + koff); } while (0)
#define SWRITE(b, i) do { *(bf16x8*)((char*)V_lds + (b) * SHM_V + vst0) = sr_[i].vs0;          \
    *(bf16x8*)((char*)V_lds + (b) * SHM_V + vst1) = sr_[i].vs1; int kc = sc * 2;               \
    *(bf16x8*)((char*)K_lds + (b) * SHM_K + KSWZ(sr, kc)) = sr_[i].ks0;                       \
    *(bf16x8*)((char*)K_lds + (b) * SHM_K + KSWZ(32 + sr, kc)) = sr_[i].ks1; } while (0)
#define SWAIT() asm volatile("s_waitcnt vmcnt(4)" ::: "memory")
#define RESC(a) do { if (__any((a) < 1.f)) { if (hi == 0) al_l[r32] = (a); asm volatile("s_waitcnt lgkmcnt(0)" ::: "memory"); \
    for (int d = 0; d < 4; ++d) for (int r = 0; r < 16; ++r) o[d][r] *= al_l[crow(r, hi)]; } } while (0)
  f32x16 pA0, pA1, pB0, pB1; float mnA, mnB, alA, alB; bf16x8 pa0, pa1, pa2, pa3; constexpr int NT = SEQ / KVBLK;
  constexpr int SE = 0, SO = 1;
  SLOAD(SE, 0); asm volatile("s_waitcnt vmcnt(0)" ::: "memory"); SWRITE(0, SE); __syncthreads();
  qkt(pA0, pA1, K_lds, qr, r32, hi); psm<FAST>(pA0, pA1, m_reg, mnA, alA);
  SLOAD(SO, KVBLK); SLOAD(SE, 2 * KVBLK);
  SWAIT(); SWRITE(1, SO); __syncthreads();
  for (int j = 1; j + 1 < NT; j += 2) {
    SBAR(); qkt(pB0, pB1, (bf16_t*)((char*)K_lds + SHM_K), qr, r32, hi);
    fsm<FAST>(pA0, pA1, alA, l_reg, pa0, pa1, pa2, pa3); SBAR();
    SLOAD(SO, (j + 2) * KVBLK); SBAR();
    pv_d0(o, vb0, pa0, pa1, pa2, pa3); psm<FAST>(pB0, pB1, m_reg, mnB, alB);
    __syncthreads(); SWAIT(); SWRITE(0, SE);
    if constexpr (!FAST) RESC(alB); __syncthreads();
    SBAR(); qkt(pA0, pA1, K_lds, qr, r32, hi);
    fsm<FAST>(pB0, pB1, alB, l_reg, pa0, pa1, pa2, pa3); SBAR();
    if (j + 3 < NT) SLOAD(SE, (j + 3) * KVBLK); SBAR();
    pv_d0(o, vb0 + (int)SHM_V, pa0, pa1, pa2, pa3); psm<FAST>(pA0, pA1, m_reg, mnA, alA);
    __syncthreads(); SWAIT(); SWRITE(1, SO);
    if constexpr (!FAST) RESC(alA); __syncthreads();
  }
  SBAR(); qkt(pB0, pB1, (bf16_t*)((char*)K_lds + SHM_K), qr, r32, hi);
  fsm<FAST>(pA0, pA1, alA, l_reg, pa0, pa1, pa2, pa3); SBAR();
  pv_d0(o, vb0, pa0, pa1, pa2, pa3); psm<FAST>(pB0, pB1, m_reg, mnB, alB);
  __syncthreads(); if constexpr (!FAST) RESC(alB);
  fsm<FAST>(pB0, pB1, alB, l_reg, pa0, pa1, pa2, pa3); SBAR();
  pv_d0(o, vb0 + (int)SHM_V, pa0, pa1, pa2, pa3);
  { int tid2 = threadIdx.x; asm volatile("" : "+v"(tid2)); const int lane2 = tid2 & 63, r32e = lane2 & 31, hie = lane2 >> 5;
    if (hie == 0) li_l[r32e] = l_reg; asm volatile("s_waitcnt lgkmcnt(0)" ::: "memory");
    float rli[16];
#pragma unroll
    for (int r = 0; r < 16; ++r) rli[r] = __builtin_amdgcn_rcpf(li_l[crow(r, hie)]);
    bf16_t* Ow = Ob + (long)(wid * QBLK) * LDO;
#pragma unroll
    for (int r = 0; r < 16; ++r) { int orow = crow(r, hie);
      for (int d0 = 0; d0 < 4; ++d0) Ow[(long)orow * LDO + d0 * 32 + r32e] = (bf16_t)(cvtpk(o[d0][r] * rli[r], 0.f) & 0xffffu); } }
  __syncthreads();
#undef SLOAD
#undef SWRITE
#undef SWAIT
#undef RESC
}

constexpr int MIXA_RUN = 8;
constexpr int MIXA_LDS_K = 0, MIXA_LDS_V = 65536, MIXA_LDS_BT = 131072, MIXA_LDS_LI = MIXA_LDS_BT + 1024, MIXA_LDS_NEG = MIXA_LDS_LI + NW * 128, MIXA_LDS_BYTES = MIXA_LDS_NEG + 768;
__device__ __forceinline__ void mixa_run(int b, int h, int br, int res, int n0, const bf16_t* __restrict__ proj, const float* __restrict__ btab,
                                         bf16_t* __restrict__ OA, float* __restrict__ LSE, char* lds) {
  int tid_ = threadIdx.x; asm volatile("" : "+v"(tid_));
  const int tid = tid_, wid = __builtin_amdgcn_readfirstlane(tid >> 6), lane = tid & 63, r32 = lane & 31, hi = lane >> 5;
  const int sh = 2 * br, nbt = 128 >> sh, q32 = wid & 3, dh = wid >> 2;
  char* K_lds = lds + MIXA_LDS_K; char* V_lds = lds + MIXA_LDS_V; float* bt = (float*)(lds + MIXA_LDS_BT); float* li_l = (float*)(lds + MIXA_LDS_LI) + wid * 32;
  const size_t rowb = (size_t)b * SEQ;
  const int sr = tid >> 4, sc = (tid & 15) * 8;
  const int kst0 = KSWZ(sr, sc * 2), kst1 = KSWZ(32 + sr, sc * 2), vst0 = v_st(sr, sc), vst1 = v_st(32 + sr, sc);
  const bf16_t* pk = proj + rowb * INW + 1024 + h * 128 + sc; const bf16_t* pv = pk + 1024;
#define MIXA_TLOAD(t, K0, K1, V0, V1) do { const int t_ = (t); const bool ok_ = (t_ >= 0) && (t_ < nbt); const int tt_ = ok_ ? t_ : 0; \
    const size_t o0_ = (size_t)(((64 * tt_ + sr) << sh) + res) * INW, o1_ = (size_t)(((64 * tt_ + 32 + sr) << sh) + res) * INW; \
    K0 = ld8(pk + o0_); K1 = ld8(pk + o1_); V0 = ld8(pv + o0_); V1 = ld8(pv + o1_); \
    if (!ok_) { K0 = bf16x8{}; K1 = bf16x8{}; V0 = bf16x8{}; V1 = bf16x8{}; } } while (0)
#define MIXA_TWRITE(slot, K0, K1, V0, V1) do { *(bf16x8*)(K_lds + (slot) + kst0) = K0; *(bf16x8*)(K_lds + (slot) + kst1) = K1; \
    *(bf16x8*)(V_lds + (slot) + vst0) = V0; *(bf16x8*)(V_lds + (slot) + vst1) = V1; } while (0)
  bf16x8 ak0, ak1, av0, av1, bk0, bk1, bv0, bv1;
  MIXA_TLOAD(n0 - 1, ak0, ak1, av0, av1); MIXA_TLOAD(n0, bk0, bk1, bv0, bv1);
  if (tid < 192) { const int idx = tid - 32; bt[tid] = (idx >= 0 && idx <= 128) ? btab[(br * 8 + h) * 132 + idx] : -1.0e30f; ((float*)(lds + MIXA_LDS_NEG))[tid] = -1.0e30f; }
  MIXA_TWRITE(0, ak0, ak1, av0, av1); MIXA_TWRITE(16384, bk0, bk1, bv0, bv1);
  MIXA_TLOAD(n0 + 1, ak0, ak1, av0, av1); MIXA_TLOAD(n0 + 2, bk0, bk1, bv0, bv1);
  bf16x8 qr[8];
  { const size_t tokq = rowb + ((size_t)(64 * n0 + 32 * q32 + r32) << sh) + res; const bf16_t* Qp = proj + tokq * INW + h * 128 + hi * 8;
#pragma unroll
    for (int d0 = 0; d0 < 8; ++d0) qr[d0] = ld8(Qp + d0 * 16); }
  MIXA_TWRITE(32768, ak0, ak1, av0, av1); MIXA_TWRITE(49152, bk0, bk1, bv0, bv1);
  __syncthreads();
  const float* btl = bt + (4 * hi - r32 + 32); const float* btn = (const float*)(lds + MIXA_LDS_NEG) + (4 * hi - r32 + 32);
  const int vbl = (int)(uintptr_t)V_lds + v_rd_base(lane) + dh * 1024;
  bf16_t* Ob0 = OA + (size_t)br * ((size_t)2 * SEQ * 1024) + h * 128 + dh * 64;
  float* Lb = LSE + (size_t)br * ((size_t)2 * SEQ * 8) + h;
  for (int s = 0; s < MIXA_RUN / 2; ++s) {
    const int nq = n0 + 2 * s, T0 = nq - 1; const bool more = (s + 1 < MIXA_RUN / 2);
    if (more) { MIXA_TLOAD(T0 + 4, ak0, ak1, av0, av1); MIXA_TLOAD(T0 + 5, bk0, bk1, bv0, bv1); }
    f32x16 p[5];
#pragma unroll
    for (int kb = 0; kb < 5; ++kb) { p[kb] = f32x16{}; const int brow = q32 + kb; const int sl = ((2 * s + (brow >> 1)) & 3) * 16384 + (brow & 1) * 8192;
#pragma unroll
      for (int d0 = 0; d0 < 8; ++d0) { const int cb = (d0 * 16 + hi * 8) * 2;
        const bf16x8 a = *reinterpret_cast<const bf16x8*>(K_lds + sl + KSWZ(r32, cb));
        p[kb] = __builtin_amdgcn_mfma_f32_32x32x16_bf16(a, qr[d0], p[kb], 0, 0, 0); }
      SBAR(); }
    const size_t tokq = rowb + ((size_t)(64 * nq + 32 * q32 + r32) << sh) + res;
    if (more) { const bf16_t* Qp = proj + (tokq + ((size_t)128 << sh)) * INW + h * 128 + hi * 8;
#pragma unroll
      for (int d0 = 0; d0 < 8; ++d0) qr[d0] = ld8(Qp + d0 * 16); }
    constexpr float C = SCALE * 1.4426950408889634f;
    float mx = -3.0e38f;
#pragma unroll
    for (int kb = 0; kb < 5; ++kb) { const int tile = (q32 + kb) >> 1;
      const float* tb = ((tile == 0 && T0 < 0) || (tile == 3 && T0 + 3 >= nbt)) ? btn : btl;
#pragma unroll
      for (int r = 0; r < 16; ++r) { const int cidx = 32 * kb + (r & 3) + 8 * (r >> 2);
        const float v = fmaf(p[kb][r], C, tb[cidx]);
        p[kb][r] = v; mx = fmaxf(mx, v); }
      SBAR(); }
    { auto rr = __builtin_amdgcn_permlane32_swap(__float_as_uint(mx), __float_as_uint(mx), false, false); mx = fmaxf(__uint_as_float(rr[0]), __uint_as_float(rr[1])); }
    float sum = 0.f;
    bf16x8 pa[10];
#pragma unroll
    for (int kb = 0; kb < 5; ++kb) {
#pragma unroll
      for (int r = 0; r < 16; ++r) { const float e = __builtin_amdgcn_exp2f(p[kb][r] - mx); p[kb][r] = e; sum += e; }
      ATT_PK4(p[kb], 0, pa[2 * kb]); ATT_PK4(p[kb], 8, pa[2 * kb + 1]); SBAR(); }
    { auto rr = __builtin_amdgcn_permlane32_swap(__float_as_uint(sum), __float_as_uint(sum), false, false); sum = __uint_as_float(rr[0]) + __uint_as_float(rr[1]); }
    f32x16 o0 = f32x16{}, o1 = f32x16{};
#define MIXA_PV(KB) do { const int brow_ = q32 + (KB); const int vb_ = vbl + ((2 * s + (brow_ >> 1)) & 3) * 16384 + (brow_ & 1) * 8192; \
      const s16x4 la_ = tr_read<0>(vb_), ha_ = tr_read<2048>(vb_), lb_ = tr_read<512>(vb_), hb_ = tr_read<512 + 2048>(vb_); \
      const s16x4 lc_ = tr_read<4096>(vb_), hc_ = tr_read<4096 + 2048>(vb_), ld_ = tr_read<4096 + 512>(vb_), hd_ = tr_read<4096 + 512 + 2048>(vb_); \
      asm volatile("s_waitcnt lgkmcnt(0)" ::: "memory"); SBAR(); \
      o0 = __builtin_amdgcn_mfma_f32_32x32x16_bf16(pa[2 * (KB)], ATT_PK(la_, ha_), o0, 0, 0, 0); o1 = __builtin_amdgcn_mfma_f32_32x32x16_bf16(pa[2 * (KB)], ATT_PK(lb_, hb_), o1, 0, 0, 0); \
      o0 = __builtin_amdgcn_mfma_f32_32x32x16_bf16(pa[2 * (KB) + 1], ATT_PK(lc_, hc_), o0, 0, 0, 0); o1 = __builtin_amdgcn_mfma_f32_32x32x16_bf16(pa[2 * (KB) + 1], ATT_PK(ld_, hd_), o1, 0, 0, 0); } while (0)
    MIXA_PV(0); MIXA_PV(1); MIXA_PV(2); MIXA_PV(3); MIXA_PV(4);
#undef MIXA_PV
    if (hi == 0) li_l[r32] = sum; asm volatile("s_waitcnt lgkmcnt(0)" ::: "memory");
    {
      char* ub = (char*)Ob0 + ((rowb + ((size_t)(64 * nq + 32 * q32) << sh) + res) * 1024) * 2;
      const unsigned loff = (((unsigned)(4 * hi) << sh) * 1024u + (unsigned)r32) * 2u;
#pragma unroll
      for (int r = 0; r < 16; ++r) { const float rl = __builtin_amdgcn_rcpf(li_l[crow(r, hi)]);
        const unsigned w = cvtpk(o0[r] * rl, o1[r] * rl);
        bf16_t* dst = (bf16_t*)(ub + ((size_t)(((r & 3) + 8 * (r >> 2)) << sh) * 2048) + loff);
        dst[0] = (bf16_t)(w & 0xffffu); dst[32] = (bf16_t)(w >> 16); } }
    if (dh == 0 && hi == 0) Lb[tokq * 8] = (mx + __builtin_amdgcn_logf(sum)) * 0.6931471805599453f;
    __syncthreads();
    if (more) { MIXA_TWRITE(((2 * s) & 3) * 16384, ak0, ak1, av0, av1); MIXA_TWRITE(((2 * s + 1) & 3) * 16384, bk0, bk1, bv0, bv1); }
    __syncthreads();
  }
#undef MIXA_TLOAD
#undef MIXA_TWRITE
}
#undef SBAR
}

constexpr int NWAVES = 8;
#ifndef MK_N_LAUNCHES
#define MK_N_LAUNCHES 1
#endif
constexpr int N_LAYERS = 2;
#ifndef I8P_MASK
#define I8P_MASK 2
#endif
#ifndef I8D_MASK
#define I8D_MASK 3
#endif
constexpr int I8D = I8D_MASK;
constexpr int I8P = I8P_MASK;
constexpr int PH_PER_LAYER = 9;
constexpr int N_PHASES = 1 + N_LAYERS * PH_PER_LAYER;
constexpr int N_LAUNCHES = MK_N_LAUNCHES;
static_assert(N_LAUNCHES == 1 || N_LAUNCHES == N_PHASES, "MK_N_LAUNCHES is 1 or 19");

constexpr int BATCH = 2, SEQ = 8192, DM = 4096, M = BATCH * SEQ, INW = 9216, FF = 16384;
constexpr int COL_QA = 0, COL_KA = 1024, COL_VA = 2048, COL_GB = 3072, COL_GC = 4096, COL_HB = 5120, COL_QC = 6144, COL_KC = 8192, COL_VC = 8704;
constexpr float EPS = 1e-6f;

constexpr size_t MiB = 1u << 20;
constexpr size_t WS_CTL = 0, WS_CMAX = 64 * 1024, WS_CMAXI = WS_CMAX + (size_t)2 * 16384 * 4, WS_CMAXD = WS_CMAXI + (size_t)2 * 9216 * 4, WS_CSUM = WS_CMAXD + (size_t)2 * 4096 * 4, CTL_ZERO_BYTES = WS_CSUM + (size_t)2 * 4096 * 4;
constexpr size_t WS_ROPE = 1 * MiB;
constexpr size_t WS_BTAB = 1 * MiB + 64 * 1024;
constexpr size_t WS_RS = 1 * MiB + 128 * 1024;
constexpr size_t WS_RMAX = 1 * MiB + 256 * 1024;
constexpr size_t WS_RF = 1 * MiB + 192 * 1024;
constexpr size_t WS_WIN = 2 * MiB, SZ_WIN = (size_t)DM * INW * 2;
constexpr size_t WS_WOUT = WS_WIN + 2 * SZ_WIN, SZ_WOUT = (size_t)DM * DM * 2;
constexpr size_t WS_WUP = WS_WOUT + 2 * SZ_WOUT, SZ_WUP = (size_t)DM * FF * 2;
constexpr size_t WS_WDN = WS_WUP + 2 * SZ_WUP, SZ_WDN = (size_t)DM * FF * 2;
constexpr size_t WS_HN = WS_WDN + 2 * SZ_WDN;
constexpr size_t WS_MIX = WS_HN + (size_t)M * DM * 2;
constexpr size_t WS_Y = WS_MIX + (size_t)M * DM * 2;
constexpr size_t WS_XQ = WS_Y + (size_t)M * DM * 2;
constexpr size_t WS_R = WS_Y + (size_t)M * DM * 4;
constexpr size_t WS_PROJ = WS_R;
constexpr size_t WS_KR = WS_PROJ + (size_t)M * INW * 2;
constexpr size_t WS_OA = WS_KR + (size_t)M * 512 * 2;
constexpr size_t WS_LSE = WS_OA + (size_t)3 * M * 1024 * 4;
constexpr size_t WS_OC = WS_LSE + (size_t)3 * M * 8 * 4;
constexpr size_t WS_END_R = WS_OC + (size_t)M * 2048 * 4;
constexpr size_t WS_H = WS_R;
constexpr size_t WS_HQ = WS_H + (size_t)M * FF * 2;
constexpr size_t WS_END = (WS_END_R > WS_HQ + (size_t)M * FF) ? WS_END_R : WS_HQ + (size_t)M * FF;
static_assert(WS_WIN % 256 == 0 && WS_OC % 256 == 0 && WS_LSE % 256 == 0, "alignment");
constexpr int CW_TMO = 0, CW_CODE = 1;
constexpr int CW_BAR = 4096;

constexpr int RING_OFF = 0, RING_BYTES = 135168;
constexpr int LDSCTL_OFF = RING_BYTES, MISC_OFF = LDSCTL_OFF + 320;
constexpr int LDS_BYTES = 147456;
static_assert(MISC_OFF + 128 <= LDS_BYTES, "LDS map");
static_assert(att::SHM_ATTN <= RING_BYTES && att::MIXA_LDS_BYTES <= RING_BYTES, "attention LDS");

#define GAS __attribute__((address_space(1)))
#define LAS __attribute__((address_space(3)))
typedef unsigned short bf16;
typedef unsigned v4u __attribute__((ext_vector_type(4)));
typedef unsigned v2u __attribute__((ext_vector_type(2)));
typedef float f32x4 __attribute__((ext_vector_type(4)));
typedef float f32x2 __attribute__((ext_vector_type(2)));
typedef GAS unsigned gu32;
#define RLX_AGENT __ATOMIC_RELAXED, __HIP_MEMORY_SCOPE_AGENT
#define LDS_WAIT() asm volatile("s_waitcnt lgkmcnt(0)" ::: "memory")
#define VM_WAIT() asm volatile("s_waitcnt vmcnt(0)" ::: "memory")
__device__ __forceinline__ unsigned f2bf(float f) { unsigned u = __builtin_bit_cast(unsigned, f); return (u + 0x7fffu + ((u >> 16) & 1u)) >> 16; }
__device__ __forceinline__ unsigned pk2(float lo, float hi) { return f2bf(lo) | (f2bf(hi) << 16); }
__device__ __forceinline__ float bflo(unsigned w) { return __uint_as_float(w << 16); }
__device__ __forceinline__ float bfhi(unsigned w) { return __uint_as_float(w & 0xffff0000u); }

#define XB_TMO      128
#define XB_XCNT(j)  (256  + 64 * (j))
#define XB_XSUB(j)  (1280 + 64 * (j))
#define XB_XGEN(j)  (2304 + 64 * (j))
#define XB_TOP      3328
#define XB_TOPGEN   3392
#define XCD_BAR_WORDS 3456
#define XB_SPIN_CAP (1u << 18)

__device__ __forceinline__ unsigned xb_ld(unsigned* p)              { return __hip_atomic_load(p, __ATOMIC_RELAXED, __HIP_MEMORY_SCOPE_AGENT); }
__device__ __forceinline__ unsigned xb_add(unsigned* p, unsigned v) { return __hip_atomic_fetch_add(p, v, __ATOMIC_RELAXED, __HIP_MEMORY_SCOPE_AGENT); }
__device__ __forceinline__ unsigned xb_xcc_id() { return (unsigned)__builtin_amdgcn_s_getreg((3 << 11) | 20) & 0xFu; }
#define XB_SPIN(cond, bar) do { unsigned _sp = 0; while (cond) { __builtin_amdgcn_s_sleep(1); \
    if ((++_sp & 255u) == 0u) { if (xb_ld(&(bar)[XB_TMO])) break; if (_sp > XB_SPIN_CAP) { atomicAdd(&(bar)[XB_TMO], 1u); break; } } } } while (0)

struct XcdBarrier {
    unsigned* bar; unsigned x;
    volatile LAS unsigned* st;
};

__device__ __forceinline__ XcdBarrier xcd_barrier_post(unsigned* bar, volatile LAS unsigned* st) {
    XcdBarrier b; b.bar = bar; b.x = xb_xcc_id(); b.st = st;
    if (threadIdx.x == 0) (void)xb_add(&bar[XB_XCNT(b.x)], 1u);
    return b;
}
__device__ __forceinline__ void xcd_barrier_complete(unsigned* bar, unsigned x, unsigned& nloc, unsigned& nx) {
    const unsigned G = gridDim.x * gridDim.y * gridDim.z;
    unsigned sum, cnt, mine, sp = 0u;
    for (;;) {
        sum = 0u; cnt = 0u; mine = 0u;
#pragma unroll
        for (unsigned j = 0; j < 16; ++j) { const unsigned c = xb_ld(&bar[XB_XCNT(j)]); sum += c; cnt += (c > 0u) ? 1u : 0u; mine = (j == x) ? c : mine; }
        if (sum == G) break;
        __builtin_amdgcn_s_sleep(1);
        if ((++sp & 255u) == 0u) { if (xb_ld(&bar[XB_TMO])) break; if (sp > XB_SPIN_CAP) { atomicAdd(&bar[XB_TMO], 1u); break; } }
    }
    nloc = mine > 0u ? mine : 1u; nx = cnt > 0u ? cnt : 1u;
}

__device__ __forceinline__ void xcd_barrier(const XcdBarrier& b) {
    asm volatile("s_waitcnt vmcnt(0)" ::: "memory");
    __syncthreads();
    if (threadIdx.x == 0) {
        unsigned* bar = b.bar;
        __builtin_amdgcn_s_waitcnt(0);
        unsigned nloc = b.st[0], nx = b.st[1];
        if (nloc == 0u) { xcd_barrier_complete(bar, b.x, nloc, nx); b.st[0] = nloc; b.st[1] = nx; }
        const unsigned old = xb_add(&bar[XB_XSUB(b.x)], 1u);
        const unsigned gen = old / nloc;
        if (old + 1u == (gen + 1u) * nloc) {
            __builtin_amdgcn_fence(__ATOMIC_RELEASE, "agent");
            asm volatile("s_waitcnt vmcnt(0)" ::: "memory");
            const unsigned og = xb_add(&bar[XB_TOP], 1u);
            const unsigned tg = og / nx;
            if (og + 1u == (tg + 1u) * nx) xb_add(&bar[XB_TOPGEN], 1u);
            else XB_SPIN(xb_ld(&bar[XB_TOPGEN]) == tg, bar);
            __builtin_amdgcn_fence(__ATOMIC_ACQUIRE, "agent");
            xb_add(&bar[XB_XGEN(b.x)], 1u);
            asm volatile("s_waitcnt vmcnt(0)" ::: "memory");
        } else {
            XB_SPIN(xb_ld(&bar[XB_XGEN(b.x)]) == gen, bar);
            __builtin_amdgcn_fence(__ATOMIC_ACQUIRE, "agent");
            asm volatile("s_waitcnt vmcnt(0)" ::: "memory");
        }
    }
    __syncthreads();
}
__device__ __forceinline__ float shx(float v, int o, int lane) { return __int_as_float(__builtin_amdgcn_ds_bpermute((lane ^ o) << 2, __float_as_int(v))); }
__device__ __forceinline__ float wave_sum(float v, int lane) {
#pragma unroll
    for (int o = 1; o < 64; o <<= 1) v += shx(v, o, lane);
    return v;
}
__device__ __forceinline__ float dot4(f32x4 a) { return (a.x * a.x + a.y * a.y) + (a.z * a.z + a.w * a.w); }
__device__ __forceinline__ v2u pk4(f32x4 a) { v2u w; w.x = pk2(a.x, a.y); w.y = pk2(a.z, a.w); return w; }

template <bool GSQ = false>
__device__ __forceinline__ void transpose_item(const float* __restrict__ W, int K, int N, bf16* __restrict__ WT, const float* __restrict__ gk, LAS float* scr, int item, int lane) {
    const int nblk = N / 32, kb = item / nblk, nb = item - kb * nblk, k0 = 64 * kb, n0 = 32 * nb;
    const int rr = lane >> 3, c4 = (lane & 7) * 4;
#pragma unroll
    for (int hb = 0; hb < 2; ++hb) {
        f32x4 v[4];
#pragma unroll
        for (int i = 0; i < 4; ++i) v[i] = *(const GAS f32x4*)(W + (size_t)(k0 + 8 * (4 * hb + i) + rr) * N + n0 + c4);
        if (gk) {
#pragma unroll
            for (int i = 0; i < 4; ++i) { float g_ = gk[k0 + 8 * (4 * hb + i) + rr]; if (GSQ) { g_ *= (1.0f / 127.0f); g_ *= g_; } v[i] = v[i] * g_; } }
#pragma unroll
        for (int i = 0; i < 4; ++i) { LAS float* d = scr + (8 * (4 * hb + i) + rr) * 33 + c4; d[0] = v[i].x; d[1] = v[i].y; d[2] = v[i].z; d[3] = v[i].w; }
        asm volatile("" ::: "memory");
    }
    LDS_WAIT(); asm volatile("" ::: "memory");
    const int c = lane & 7;
#pragma unroll
    for (int j = 0; j < 4; ++j) { const int n = (lane >> 3) + 8 * j; const LAS float* s = scr + (8 * c) * 33 + n;
        v4u o; o.x = pk2(s[0 * 33], s[1 * 33]); o.y = pk2(s[2 * 33], s[3 * 33]); o.z = pk2(s[4 * 33], s[5 * 33]); o.w = pk2(s[6 * 33], s[7 * 33]);
        *(GAS v4u*)(WT + ((((size_t)(n0 >> 8) * (K / 64) + kb) * 256 + (n0 & 255) + n) * 64 + 8 * c)) = o; }
    LDS_WAIT(); asm volatile("" ::: "memory");
}
__device__ __forceinline__ void colmax_item(const float* __restrict__ W, int N, const float* __restrict__ gk, unsigned* __restrict__ cmax, int item, int lane, int krows = 512) {
    const int nblk = N / 32, kb = item / nblk, nb = item - kb * nblk, k0 = krows * kb, n0 = 32 * nb;
    const int rr = lane >> 3, c4 = (lane & 7) * 4;
    f32x4 mx = {0.f, 0.f, 0.f, 0.f};
    for (int i0 = 0; i0 < (krows >> 3); i0 += 16) {
        f32x4 v[16];
#pragma unroll
        for (int i = 0; i < 16; ++i) v[i] = *(const GAS f32x4*)(W + (size_t)(k0 + 8 * (i0 + i) + rr) * N + n0 + c4);
#pragma unroll
        for (int i = 0; i < 16; ++i) { const float g_ = gk ? gk[k0 + 8 * (i0 + i) + rr] : 1.0f; const f32x4 t = v[i] * g_;
            mx.x = fmaxf(mx.x, fabsf(t.x)); mx.y = fmaxf(mx.y, fabsf(t.y)); mx.z = fmaxf(mx.z, fabsf(t.z)); mx.w = fmaxf(mx.w, fabsf(t.w)); }
        asm volatile("" ::: "memory");
    }
#pragma unroll
    for (int o = 8; o < 64; o <<= 1) { mx.x = fmaxf(mx.x, shx(mx.x, o, lane)); mx.y = fmaxf(mx.y, shx(mx.y, o, lane)); mx.z = fmaxf(mx.z, shx(mx.z, o, lane)); mx.w = fmaxf(mx.w, shx(mx.w, o, lane)); }
    if (lane < 8) { unsigned* d = cmax + n0 + c4;
        __hip_atomic_fetch_max(d + 0, __float_as_uint(mx.x), __ATOMIC_RELAXED, __HIP_MEMORY_SCOPE_AGENT); __hip_atomic_fetch_max(d + 1, __float_as_uint(mx.y), __ATOMIC_RELAXED, __HIP_MEMORY_SCOPE_AGENT);
        __hip_atomic_fetch_max(d + 2, __float_as_uint(mx.z), __ATOMIC_RELAXED, __HIP_MEMORY_SCOPE_AGENT); __hip_atomic_fetch_max(d + 3, __float_as_uint(mx.w), __ATOMIC_RELAXED, __HIP_MEMORY_SCOPE_AGENT); }
}
__device__ __forceinline__ int q8(float v) { int q = (int)rintf(v); q = q < -127 ? -127 : q; return q > 127 ? 127 : q; }
__device__ __forceinline__ int q8u(float v) { int q = (int)rintf(v); q = q > 255 ? 255 : q; return (q < 0 ? 0 : q) - 128; }
__device__ __forceinline__ unsigned pkq4(int a, int b, int c, int d) { return (unsigned)(a & 255) | ((unsigned)(b & 255) << 8) | ((unsigned)(c & 255) << 16) | ((unsigned)d << 24); }
__device__ __forceinline__ void transpose_item_q(const float* __restrict__ W, int K, int N, signed char* __restrict__ WQ, const float* __restrict__ gk, const unsigned* __restrict__ cmax, LAS float* scr, int item, int lane, int* csum = nullptr) {
    const int nblk = N / 32, kb = item / nblk, nb = item - kb * nblk, k0 = 64 * kb, n0 = 32 * nb;
    const int rr = lane >> 3, c4 = (lane & 7) * 4;
#pragma unroll
    for (int hb = 0; hb < 2; ++hb) {
        f32x4 v[4];
#pragma unroll
        for (int i = 0; i < 4; ++i) v[i] = *(const GAS f32x4*)(W + (size_t)(k0 + 8 * (4 * hb + i) + rr) * N + n0 + c4);
#pragma unroll
        for (int i = 0; i < 4; ++i) { if (gk) v[i] = v[i] * gk[k0 + 8 * (4 * hb + i) + rr]; }
#pragma unroll
        for (int i = 0; i < 4; ++i) { LAS float* d = scr + (8 * (4 * hb + i) + rr) * 33 + c4; d[0] = v[i].x; d[1] = v[i].y; d[2] = v[i].z; d[3] = v[i].w; }
        asm volatile("" ::: "memory");
    }
    LDS_WAIT(); asm volatile("" ::: "memory");
    const int c = lane & 3;
#pragma unroll
    for (int j = 0; j < 2; ++j) { const int n = (lane >> 2) + 16 * j; const LAS float* s = scr + (16 * c) * 33 + n;
        const float inv = 127.0f / fmaxf(__uint_as_float(cmax[n0 + n]), 1e-30f);
        int q[16];
#pragma unroll
        for (int e = 0; e < 16; ++e) q[e] = q8(s[e * 33] * inv);
        v4u o; o.x = pkq4(q[0], q[1], q[2], q[3]); o.y = pkq4(q[4], q[5], q[6], q[7]); o.z = pkq4(q[8], q[9], q[10], q[11]); o.w = pkq4(q[12], q[13], q[14], q[15]);
        if (csum) { int t = 0;
#pragma unroll
            for (int e = 0; e < 16; ++e) t += q[e];
            t += __builtin_amdgcn_ds_bpermute((lane ^ 1) << 2, t); t += __builtin_amdgcn_ds_bpermute((lane ^ 2) << 2, t);
            if (c == 0) (void)__hip_atomic_fetch_add(csum + n0 + n, t, __ATOMIC_RELAXED, __HIP_MEMORY_SCOPE_AGENT); }
        *(GAS v4u*)(WQ + ((((size_t)(n0 >> 8) * (K / 128) + (k0 >> 7)) * 256 + (n0 & 255) + n) * 128 + (k0 & 127) + 16 * c)) = o; }
    LDS_WAIT(); asm volatile("" ::: "memory");
}
__device__ __forceinline__ void unpack8(v4u w, float (&f)[8]) { f[0] = bflo(w.x); f[1] = bfhi(w.x); f[2] = bflo(w.y); f[3] = bfhi(w.y); f[4] = bflo(w.z); f[5] = bfhi(w.z); f[6] = bflo(w.w); f[7] = bfhi(w.w); }
__device__ __forceinline__ v4u pack8(const float (&o)[8]) { v4u w; w.x = pk2(o[0], o[1]); w.y = pk2(o[2], o[3]); w.z = pk2(o[4], o[5]); w.w = pk2(o[6], o[7]); return w; }
template <bool QUANT>
__device__ __forceinline__ void cast_row(const float* __restrict__ xrow, bf16* __restrict__ xbrow, float* rs_out, int lane, signed char* xqrow = nullptr, float* rf_out = nullptr) {
    f32x4 x[8][2]; float s = 0.f, am = 0.f;
#pragma unroll
    for (int j = 0; j < 8; ++j) { x[j][0] = *(const GAS f32x4*)(xrow + 8 * lane + 512 * j); x[j][1] = *(const GAS f32x4*)(xrow + 8 * lane + 512 * j + 4); }
#pragma unroll
    for (int j = 0; j < 8; ++j) { s += dot4(x[j][0]) + dot4(x[j][1]);
        if (QUANT) {
#pragma unroll
            for (int e = 0; e < 4; ++e) am = fmaxf(am, fmaxf(fabsf(x[j][0][e]), fabsf(x[j][1][e]))); }
        else { v4u w; w.x = pk2(x[j][0].x, x[j][0].y); w.y = pk2(x[j][0].z, x[j][0].w); w.z = pk2(x[j][1].x, x[j][1].y); w.w = pk2(x[j][1].z, x[j][1].w);
            *(GAS v4u*)(xbrow + 8 * lane + 512 * j) = w; } }
    const float tot = wave_sum(s, lane); const float rsn = 1.0f / sqrtf(tot * (1.0f / DM) + EPS);
    if (lane == 0) *rs_out = rsn;
    if (QUANT) {
#pragma unroll
        for (int o = 1; o < 64; o <<= 1) am = fmaxf(am, shx(am, o, lane));
        am = fmaxf(am, 1e-30f); const float inv = 127.0f / am;
#pragma unroll
        for (int j = 0; j < 8; ++j) { v2u q;
            q.x = pkq4(q8(x[j][0].x * inv), q8(x[j][0].y * inv), q8(x[j][0].z * inv), q8(x[j][0].w * inv)); q.y = pkq4(q8(x[j][1].x * inv), q8(x[j][1].y * inv), q8(x[j][1].z * inv), q8(x[j][1].w * inv));
            *(GAS v2u*)(xqrow + 8 * lane + 512 * j) = q; }
        if (lane == 0) *rf_out = rsn * am * (1.0f / 127.0f); }
}
template <bool XF32, bool FINAL, bool QUANT = false>
__device__ __forceinline__ void resid_row(const bf16* __restrict__ yrow, const void* xrow, float* orow, bf16* xbrow, float* rs_out, const float* __restrict__ gpost, float eps_y, int lane,
                                          signed char* xqrow = nullptr, float* rf_out = nullptr) {
    v4u yraw[8]; f32x4 xf[8][2]; v4u xr[8]; float s = 0.f; float am = 0.f;
#pragma unroll
    for (int j = 0; j < 8; ++j) yraw[j] = *(const GAS v4u*)(yrow + 8 * lane + 512 * j);
#pragma unroll
    for (int j = 0; j < 8; ++j) {
        if (XF32) { xf[j][0] = *(const GAS f32x4*)((const float*)xrow + 8 * lane + 512 * j); xf[j][1] = *(const GAS f32x4*)((const float*)xrow + 8 * lane + 512 * j + 4); }
        else xr[j] = *(const GAS v4u*)((const bf16*)xrow + 8 * lane + 512 * j); }
#pragma unroll
    for (int j = 0; j < 8; ++j) { float yf[8]; unpack8(yraw[j], yf);
#pragma unroll
        for (int e = 0; e < 8; ++e) s += yf[e] * yf[e]; }
    const float rstd = 1.0f / sqrtf(wave_sum(s, lane) * (1.0f / DM) + eps_y);
    float s2 = 0.f;
#pragma unroll
    for (int j = 0; j < 8; ++j) { const int c = 8 * lane + 512 * j; float yf[8], x[8]; unpack8(yraw[j], yf);
        if (XF32) { x[0] = xf[j][0].x; x[1] = xf[j][0].y; x[2] = xf[j][0].z; x[3] = xf[j][0].w; x[4] = xf[j][1].x; x[5] = xf[j][1].y; x[6] = xf[j][1].z; x[7] = xf[j][1].w; }
        else unpack8(xr[j], x);
        const f32x4 g0 = *(const GAS f32x4*)(gpost + c), g1 = *(const GAS f32x4*)(gpost + c + 4);
#pragma unroll
        for (int e = 0; e < 4; ++e) { x[e] += yf[e] * rstd * g0[e]; x[4 + e] += yf[4 + e] * rstd * g1[e]; }
        if (FINAL) { *(GAS f32x4*)(orow + c) = (f32x4){x[0], x[1], x[2], x[3]}; *(GAS f32x4*)(orow + c + 4) = (f32x4){x[4], x[5], x[6], x[7]}; }
        else {
#pragma unroll
            for (int e = 0; e < 8; ++e) s2 += x[e] * x[e];
            const v4u pw = pack8(x); *(GAS v4u*)(xbrow + c) = pw;
            if (QUANT) { xr[j] = pw;
#pragma unroll
                for (int e = 0; e < 8; ++e) am = fmaxf(am, fabsf(x[e])); } }
        if (j & 1) asm volatile("" ::: "memory"); }
    if (!FINAL) { const float tot = wave_sum(s2, lane); const float rsn = 1.0f / sqrtf(tot * (1.0f / DM) + EPS); if (lane == 0) *rs_out = rsn;
        if (QUANT) {
#pragma unroll
            for (int o = 1; o < 64; o <<= 1) am = fmaxf(am, shx(am, o, lane));
            am = fmaxf(am * 1.00390625f, 1e-30f);
            const float inv = 127.0f / am;
#pragma unroll
            for (int j = 0; j < 8; ++j) { float x[8]; unpack8(xr[j], x); v2u q;
                q.x = pkq4(q8(x[0] * inv), q8(x[1] * inv), q8(x[2] * inv), q8(x[3] * inv)); q.y = pkq4(q8(x[4] * inv), q8(x[5] * inv), q8(x[6] * inv), q8(x[7] * inv));
                *(GAS v2u*)(xqrow + 8 * lane + 512 * j) = q; }
            if (lane == 0) *rf_out = rsn * am * (1.0f / 127.0f); } }
}
__device__ __forceinline__ void krope_row(const bf16* __restrict__ prow, bf16* __restrict__ krow, const float* __restrict__ kg, const f32x2* __restrict__ rtab, int t, int lane) {
    const int head = lane >> 4, chunk = lane & 15;
    const v4u raw = *(const GAS v4u*)(prow + COL_KC + head * 128 + chunk * 8);
    float v[8]; unpack8(raw, v); float ss = 0.f;
#pragma unroll
    for (int e = 0; e < 8; ++e) ss += v[e] * v[e];
    ss += shx(ss, 1, lane); ss += shx(ss, 2, lane); ss += shx(ss, 4, lane); ss += shx(ss, 8, lane);
    const float rstd = 1.0f / sqrtf(ss * (1.0f / 128.0f) + EPS);
    const int pos = (chunk < 8) ? (t >> 6) : (t & 63), i0 = (chunk & 3) * 8; const bool second = (chunk & 4) != 0;
    float o[8];
#pragma unroll
    for (int e = 0; e < 8; ++e) { v[e] *= rstd * kg[chunk * 8 + e]; }
#pragma unroll
    for (int e = 0; e < 8; ++e) { const float pr = shx(v[e], 4, lane); const f32x2 cs = rtab[pos * 32 + i0 + e];
        o[e] = second ? (v[e] * cs.x + pr * cs.y) : (v[e] * cs.x - pr * cs.y); }
    v4u w; w.x = pk2(o[0], o[1]); w.y = pk2(o[2], o[3]); w.z = pk2(o[4], o[5]); w.w = pk2(o[6], o[7]);
    *(GAS v4u*)(krow + head * 128 + chunk * 8) = w;
}
__device__ __forceinline__ void conv_row(const bf16* __restrict__ prow, bf16* __restrict__ mrow, const float* __restrict__ cw, const float* __restrict__ gb_gain, int t, int lane) {
    float ob[2][8]; float s = 0.f;
#pragma unroll
    for (int j = 0; j < 2; ++j) { const int c = 8 * lane + 512 * j;
        const v4u z = {0u, 0u, 0u, 0u};
        const v4u rgb = *(const GAS v4u*)(prow + COL_GB + c), rgc = *(const GAS v4u*)(prow + COL_GC + c), rhb = *(const GAS v4u*)(prow + COL_HB + c);
        v4u rgcm = z, rhbm = z, rgcp = z, rhbp = z;
        if (t > 0) { rgcm = *(const GAS v4u*)(prow - INW + COL_GC + c); rhbm = *(const GAS v4u*)(prow - INW + COL_HB + c); }
        if (t < SEQ - 1) { rgcp = *(const GAS v4u*)(prow + INW + COL_GC + c); rhbp = *(const GAS v4u*)(prow + INW + COL_HB + c); }
        float gb[8], gc[8], hb[8], gcm[8], hbm[8], gcp[8], hbp[8];
        unpack8(rgb, gb); unpack8(rgc, gc); unpack8(rhb, hb); unpack8(rgcm, gcm); unpack8(rhbm, hbm); unpack8(rgcp, gcp); unpack8(rhbp, hbp);
#pragma unroll
        for (int e = 0; e < 8; ++e) { const float w0 = cw[c + e], w1 = cw[1024 + c + e], w2 = cw[2048 + c + e];
            const float y = w0 * (gcm[e] * hbm[e]) + w1 * (gc[e] * hb[e]) + w2 * (gcp[e] * hbp[e]);
            ob[j][e] = gb[e] * y; s += ob[j][e] * ob[j][e]; } }
    const float rstd = 1.0f / sqrtf(wave_sum(s, lane) * (1.0f / 1024.0f) + EPS);
#pragma unroll
    for (int j = 0; j < 2; ++j) { const int c = 8 * lane + 512 * j; float o[8];
#pragma unroll
        for (int e = 0; e < 8; ++e) o[e] = ob[j][e] * rstd * gb_gain[c + e];
        v4u w; w.x = pk2(o[0], o[1]); w.y = pk2(o[2], o[3]); w.z = pk2(o[4], o[5]); w.w = pk2(o[6], o[7]);
        *(GAS v4u*)(mrow + 1024 + c) = w; }
}
__device__ __forceinline__ void mix_row(const bf16* __restrict__ OA, const float* __restrict__ LSE, const bf16* __restrict__ OC, bf16* __restrict__ mrow,
                                        const float* __restrict__ ga, const float* __restrict__ gc, int m, int lane) {
    v4u ra[2][3], rc[4];
#pragma unroll
    for (int j = 0; j < 2; ++j) { const int c = 8 * lane + 512 * j;
#pragma unroll
        for (int b = 0; b < 3; ++b) ra[j][b] = *(const GAS v4u*)(OA + ((size_t)b * M + m) * 1024 + c); }
#pragma unroll
    for (int j = 0; j < 4; ++j) rc[j] = *(const GAS v4u*)(OC + (size_t)m * 2048 + 8 * lane + 512 * j);
    { float oa[2][8]; float s = 0.f;
#pragma unroll
      for (int j = 0; j < 2; ++j) { const int head = (lane >> 4) + 4 * j;
        const float l0 = LSE[(size_t)m * 8 + head], l1 = LSE[((size_t)M + m) * 8 + head], l2 = LSE[((size_t)2 * M + m) * 8 + head];
        const float mx = fmaxf(l0, fmaxf(l1, l2)); const float e0 = __expf(l0 - mx), e1 = __expf(l1 - mx), e2 = __expf(l2 - mx); const float inv = 1.0f / (e0 + e1 + e2);
        float a0[8], a1[8], a2[8]; unpack8(ra[j][0], a0); unpack8(ra[j][1], a1); unpack8(ra[j][2], a2);
#pragma unroll
        for (int e = 0; e < 8; ++e) { oa[j][e] = a0[e] * (e0 * inv) + a1[e] * (e1 * inv) + a2[e] * (e2 * inv); s += oa[j][e] * oa[j][e]; } }
      const float rstd = 1.0f / sqrtf(wave_sum(s, lane) * (1.0f / 1024.0f) + EPS);
#pragma unroll
      for (int j = 0; j < 2; ++j) { const int c = 8 * lane + 512 * j; float o[8];
        const f32x4 g0 = *(const GAS f32x4*)(ga + c), g1 = *(const GAS f32x4*)(ga + c + 4);
#pragma unroll
        for (int e = 0; e < 4; ++e) { o[e] = oa[j][e] * rstd * g0[e]; o[4 + e] = oa[j][4 + e] * rstd * g1[e]; }
        *(GAS v4u*)(mrow + c) = pack8(o); } }
    { float oc[4][8]; float s = 0.f;
#pragma unroll
      for (int j = 0; j < 4; ++j) { unpack8(rc[j], oc[j]);
#pragma unroll
        for (int e = 0; e < 8; ++e) s += oc[j][e] * oc[j][e]; }
      const float rstd = 1.0f / sqrtf(wave_sum(s, lane) * (1.0f / 2048.0f) + EPS);
#pragma unroll
      for (int j = 0; j < 4; ++j) { const int c = 8 * lane + 512 * j; float o[8];
        const f32x4 g0 = *(const GAS f32x4*)(gc + c), g1 = *(const GAS f32x4*)(gc + c + 4);
#pragma unroll
        for (int e = 0; e < 4; ++e) { o[e] = oc[j][e] * rstd * g0[e]; o[4 + e] = oc[j][4 + e] * rstd * g1[e]; }
        *(GAS v4u*)(mrow + 2048 + c) = pack8(o); } }
}
__device__ __forceinline__ int t5_bucket(int rel) {
    const int n = rel < 0 ? -rel : rel; const int base = rel > 0 ? 16 : 0;
    if (n < 8) return base + n;
    const float nf = (float)n;
    int large = 8 + (int)(logf(nf / 8.0f) / 4.852030263919617f * 8.0f);
    large = large < 15 ? large : 15;
    return base + large;
}

struct Args { const float* in[16]; float* out; unsigned char* ws; int ph_lo, ph_hi, li, pad; };
typedef const __attribute__((address_space(4))) Args* ArgsP;
__device__ __forceinline__ ArgsP fresh_args() { ArgsP p = (ArgsP)__builtin_amdgcn_kernarg_segment_ptr(); asm volatile("" : "+s"(p)); return p; }
#define FRESH_LANE() ({ int l_ = threadIdx.x & 63; asm volatile("" : "+v"(l_)); l_; })
#ifndef PH_MASK
#define PH_MASK 0x3ff
#endif
#define PH_ON(i) (((PH_MASK) >> (i)) & 1)
#ifndef GEMM_WGM_N4096
#define GEMM_WGM_N4096 4
#endif
#ifndef REPEAT_MASK
#define REPEAT_MASK 0
#endif
#define PH_REP(i) for (int rep_ = 0; rep_ < 1 + (((REPEAT_MASK) >> (i)) & 1); ++rep_)

__global__ void __launch_bounds__(NWAVES * 64, 2) enc_fwd(Args args) {
    extern __shared__ __attribute__((aligned(16))) unsigned char lds[];
    const int wave = __builtin_amdgcn_readfirstlane(threadIdx.x >> 6);
    const int G = gridDim.x, bx = blockIdx.x, vcu = (G % 8 == 0) ? (bx % 8) * (G / 8) + bx / 8 : bx;
    const int gw = vcu * NWAVES + wave, NGW = G * NWAVES;
    LAS unsigned char* ldsl = (LAS unsigned char*)lds;
    volatile LAS unsigned* MISC = (volatile LAS unsigned*)(ldsl + MISC_OFF);
    for (int u = threadIdx.x; u < (LDS_BYTES - LDSCTL_OFF) / 4; u += NWAVES * 64) ((LAS unsigned*)(ldsl + LDSCTL_OFF))[u] = 0u;
    __syncthreads();
    XcdBarrier bar; bar.bar = (unsigned*)((gu32*)(args.ws + WS_CTL) + CW_BAR); bar.x = 0; bar.st = nullptr;
    if (N_LAUNCHES == 1) bar = xcd_barrier_post((unsigned*)((gu32*)(args.ws + WS_CTL) + CW_BAR), MISC + 8);
#define GRID_BAR() do { if (N_LAUNCHES == 1) { xcd_barrier(bar); } } while (0)
    const int lo = args.ph_lo, hi = args.ph_hi;
#define IN(k) (lo <= (k) && (k) < hi)
#define BOTH(k) (IN(k) && IN((k) + 1))

    if (PH_ON(0) && IN(0)) {
        PH_REP(0) {
        ArgsP ap = fresh_args(); unsigned char* ws = ap->ws;
        LAS float* scr = (LAS float*)(ldsl + RING_OFF + wave * 9216);
        constexpr int I_IN = (DM / 64) * (INW / 32), I_OUT = (DM / 64) * (DM / 32), I_UP = (DM / 64) * (FF / 32), I_DN = (FF / 64) * (DM / 32);
        constexpr int I_CM = (DM / 512) * (FF / 32), I_CMI = (DM / 128) * (INW / 32);
        constexpr int I_CMD = (FF / 128) * (DM / 32);
        constexpr int LA0 = I_CM + ((I8P & 1) ? I_CMI : I_IN) + I_OUT + ((I8D & 1) ? I_CMD : I_DN), LA1 = I_CM + ((I8P & 2) ? I_CMI : I_IN) + I_OUT + ((I8D & 2) ? I_CMD : I_DN);
        constexpr int LB0 = I_UP + ((I8P & 1) ? I_IN : 0) + ((I8D & 1) ? I_DN : 0), LB1 = I_UP + ((I8P & 2) ? I_IN : 0) + ((I8D & 2) ? I_DN : 0);
        const int lnp = FRESH_LANE();
        { const int ln = FRESH_LANE(); const float* x_in = ap->in[0]; bf16* XB = (bf16*)(ws + WS_HN); float* RS = (float*)(ws + WS_RS);
          for (int m = gw; m < M; m += NGW) { if (I8P & 1) cast_row<true>(x_in + (size_t)m * DM, nullptr, RS + m, ln, (signed char*)(ws + WS_XQ) + (size_t)m * DM, (float*)(ws + WS_RF) + m); else cast_row<false>(x_in + (size_t)m * DM, XB + (size_t)m * DM, RS + m, ln); } }
        for (int it = gw; it < LA0 + LA1; it += NGW) {
            const int layer = it >= LA0 ? 1 : 0; int r = it - (layer ? LA0 : 0); const bool qin = ((I8P >> layer) & 1) != 0;
            if (r < I_CM) { colmax_item(ap->in[13] + (size_t)layer * DM * FF, FF, ap->in[12] + layer * DM, (unsigned*)(ws + WS_CMAX) + layer * FF, r, lnp); continue; } r -= I_CM;
            if (qin) { if (r < I_CMI) { colmax_item(ap->in[3] + (size_t)layer * DM * INW, INW, ap->in[2] + layer * DM, (unsigned*)(ws + WS_CMAXI) + layer * INW, r, lnp, 128); continue; } r -= I_CMI; }
            else { if (r < I_IN) { transpose_item(ap->in[3] + (size_t)layer * DM * INW, DM, INW, (bf16*)(ws + WS_WIN + layer * SZ_WIN), ap->in[2] + layer * DM, scr, r, lnp); continue; } r -= I_IN; }
            if (r < I_OUT) { transpose_item(ap->in[10] + (size_t)layer * DM * DM, DM, DM, (bf16*)(ws + WS_WOUT + layer * SZ_WOUT), nullptr, scr, r, lnp); continue; } r -= I_OUT;
            if ((I8D >> layer) & 1) colmax_item(ap->in[14] + (size_t)layer * FF * DM, DM, nullptr, (unsigned*)(ws + WS_CMAXD) + layer * DM, r, lnp, 128);
            else transpose_item(ap->in[14] + (size_t)layer * FF * DM, FF, DM, (bf16*)(ws + WS_WDN + layer * SZ_WDN), nullptr, scr, r, lnp);
        }
        { const int gt = bx * (NWAVES * 64) + (int)threadIdx.x; f32x2* rtab = (f32x2*)(ws + WS_ROPE); float* btab = (float*)(ws + WS_BTAB);
          if (gt < 4096) { const int pos = gt >> 5, i = gt & 31; const float inv = (float)pow(10000.0, -(double)i / 32.0); const float ang = (float)pos * inv;
              f32x2 cs; cs.x = cosf(ang); cs.y = sinf(ang); rtab[gt] = cs; }
          else if (gt < 4096 + 3 * 8 * 132) { const int e = gt - 4096, br = e / (8 * 132), h = (e / 132) % 8, k = e % 132; float v = 0.f;
              if (k < 129) { const int rel = (k - 64) << (2 * br); v = ap->in[1][t5_bucket(rel) * 8 + h] * 1.4426950408889634f; }
              btab[e] = v; } }
        GRID_BAR();
        { const int lnq = FRESH_LANE();
          for (int itr = gw; itr < LB0 + LB1; itr += NGW) { const int it = LB0 + LB1 - 1 - itr;
            const int layer = it >= LB0 ? 1 : 0; int r = it - (layer ? LB0 : 0); const unsigned* cm = (const unsigned*)(ws + WS_CMAX) + layer * FF; const bool qin = ((I8P >> layer) & 1) != 0;
            if (r < I_UP) { transpose_item_q(ap->in[13] + (size_t)layer * DM * FF, DM, FF, (signed char*)(ws + WS_WUP + layer * SZ_WUP), ap->in[12] + layer * DM, cm, scr, r, lnq); continue; } r -= I_UP;
            if (qin) { if (r < I_IN) { transpose_item_q(ap->in[3] + (size_t)layer * DM * INW, DM, INW, (signed char*)(ws + WS_WIN + layer * SZ_WIN), ap->in[2] + layer * DM, (const unsigned*)(ws + WS_CMAXI) + layer * INW, scr, r, lnq); continue; } r -= I_IN; }
            transpose_item_q(ap->in[14] + (size_t)layer * FF * DM, FF, DM, (signed char*)(ws + WS_WDN + layer * SZ_WDN), nullptr, (const unsigned*)(ws + WS_CMAXD) + layer * DM, scr, r, lnq, (int*)(ws + WS_CSUM) + layer * DM); } }
        }
        __syncthreads();
    }

    for (int layer = 0; layer < N_LAYERS; ++layer) {
        const int pb = 1 + layer * PH_PER_LAYER;
        if (PH_ON(1) && IN(pb + 0)) {
            PH_REP(1) {
            ArgsP ap = fresh_args(); unsigned char* ws = ap->ws;
            int bxl = bx; asm volatile("" : "+s"(bxl));
            if ((I8P >> layer) & 1) {
            pg8::Gemm g{(const bf16*)(ws + WS_XQ), (const bf16*)(ws + WS_WIN + layer * SZ_WIN), M, INW, DM / 2}; pg8::StaticOrder S; S.init(M, INW, G, bxl);
            pg8::EpiI8P E{(bf16*)(ws + WS_PROJ), INW, (const float*)(ws + WS_RF), (const unsigned*)(ws + WS_CMAXI) + layer * INW};
            pg8::gemm_phase<pg8::EpiI8P, pg8::StaticOrder, true, true, false, true, true>(ldsl + RING_OFF, g, S, E);
            } else {
            pg8::Gemm g{(const bf16*)(ws + WS_HN), (const bf16*)(ws + WS_WIN + layer * SZ_WIN), M, INW, DM}; pg8::StaticOrder S; S.init(M, INW, G, bxl);
            pg8::EpiBf16<0> E{(bf16*)(ws + WS_PROJ), INW, (const float*)(ws + WS_RS)};
            pg8::gemm_phase<pg8::EpiBf16<0>, pg8::StaticOrder, true, true, false, true>(ldsl + RING_OFF, g, S, E);
            }
            }
            if (BOTH(pb + 0)) GRID_BAR();
        }
        if (PH_ON(2) && IN(pb + 1)) {
            PH_REP(2) {
            ArgsP ap = fresh_args(); unsigned char* ws = ap->ws;
            const bf16* PROJ = (const bf16*)(ws + WS_PROJ);
            { const float* kg = ap->in[6] + layer * 128; const float* cw = ap->in[4] + layer * 3 * 1024; const float* gbg = ap->in[8] + layer * 1024;
              bf16* KR = (bf16*)(ws + WS_KR); bf16* MIX = (bf16*)(ws + WS_MIX); const f32x2* rtab = (const f32x2*)(ws + WS_ROPE);
              const int ln = FRESH_LANE(); for (int m = gw; m < M; m += NGW) { const bf16* prow = PROJ + (size_t)m * INW; const int t = m & (SEQ - 1);
                krope_row(prow, KR + (size_t)m * 512, kg, rtab, t, ln);
                conv_row(prow, MIX + (size_t)m * DM, cw, gbg, t, ln); } }
            __syncthreads();
            { const float* btab = (const float*)(ws + WS_BTAB); bf16* OA = (bf16*)(ws + WS_OA); float* LSE = (float*)(ws + WS_LSE);
              for (int R = bx; R < 6144 / att::MIXA_RUN; R += G) { const int rn0 = (R & 15) * att::MIXA_RUN, tt = R >> 4, br = tt % 3, bh = tt / 3, sh = 2 * br;
                att::mixa_run(bh >> 3, bh & 7, br, rn0 >> (7 - sh), rn0 & ((128 >> sh) - 1), PROJ, btab, OA, LSE, (char*)lds + RING_OFF); } }
            }
            if (BOTH(pb + 1)) GRID_BAR();
        }
        if (PH_ON(3) && IN(pb + 2)) {
            PH_REP(3) {
            ArgsP ap = fresh_args(); unsigned char* ws = ap->ws;
            const float* qg = ap->in[5] + layer * 128; const bf16* PROJ = (const bf16*)(ws + WS_PROJ); const bf16* KR = (const bf16*)(ws + WS_KR); bf16* OC = (bf16*)(ws + WS_OC);
            const att::f32x2a* rtab = (const att::f32x2a*)(ws + WS_ROPE);
            bool fastsm;
            { const float* kg = ap->in[6] + layer * 128; float gq = 0.f, gk = 0.f;
              for (int i_ = 0; i_ < 128; ++i_) { gq = fmaxf(gq, fabsf(qg[i_])); gk = fmaxf(gk, fabsf(kg[i_])); }
              const float bound = 128.0f * att::SCALE * 1.4426950408889634f * 1.02f * gq * gk;
              fastsm = __builtin_amdgcn_readfirstlane((int)(bound <= 64.0f)) != 0; }
            if (wave >= 4) __builtin_amdgcn_s_setprio(1);
            if (fastsm) {
            for (int i = 0; ; ++i) { const int U = (G == 256) ? (vcu >> 5) * 128 + i * 32 + (vcu & 31) : i * G + bx; if (i * G >= 1024 || U >= 1024) break;
                const int xk = U >> 7, g4 = (U >> 5) & 3, qb = U & 31, b = xk >> 2, kvh = xk & 3, h = kvh * 4 + g4;
                att::attn_dense_body<true>(PROJ + ((size_t)b * SEQ + qb * 256) * INW + COL_QC + h * 128, KR + (size_t)b * SEQ * 512 + kvh * 128, PROJ + (size_t)b * SEQ * INW + COL_VC + kvh * 128,
                                     OC + ((size_t)b * SEQ + qb * 256) * 2048 + h * 128, qb * 256, qg, rtab, (char*)lds + RING_OFF); }
            } else {
            for (int i = 0; ; ++i) { const int U = (G == 256) ? (vcu >> 5) * 128 + i * 32 + (vcu & 31) : i * G + bx; if (i * G >= 1024 || U >= 1024) break;
                const int xk = U >> 7, g4 = (U >> 5) & 3, qb = U & 31, b = xk >> 2, kvh = xk & 3, h = kvh * 4 + g4;
                att::attn_dense_body<false>(PROJ + ((size_t)b * SEQ + qb * 256) * INW + COL_QC + h * 128, KR + (size_t)b * SEQ * 512 + kvh * 128, PROJ + (size_t)b * SEQ * INW + COL_VC + kvh * 128,
                                     OC + ((size_t)b * SEQ + qb * 256) * 2048 + h * 128, qb * 256, qg, rtab, (char*)lds + RING_OFF); }
            }
            __builtin_amdgcn_s_setprio(0);
            }
            if (BOTH(pb + 2)) GRID_BAR();
        }
        if (PH_ON(4) && IN(pb + 3)) {
            PH_REP(4) {
            ArgsP ap = fresh_args(); unsigned char* ws = ap->ws;
            const float* ga = ap->in[7] + layer * 1024; const float* gc = ap->in[9] + layer * 2048;
            const bf16* OA = (const bf16*)(ws + WS_OA); const float* LSE = (const float*)(ws + WS_LSE); const bf16* OC = (const bf16*)(ws + WS_OC); bf16* MIX = (bf16*)(ws + WS_MIX);
            { const int ln = FRESH_LANE(); for (int m = gw; m < M; m += NGW) mix_row(OA, LSE, OC, MIX + (size_t)m * DM, ga, gc, m, ln); }
            }
            if (BOTH(pb + 3)) GRID_BAR();
        }
        if (PH_ON(5) && IN(pb + 4)) {
            PH_REP(5) {
            ArgsP ap = fresh_args(); unsigned char* ws = ap->ws;
            pg8::Gemm g{(const bf16*)(ws + WS_MIX), (const bf16*)(ws + WS_WOUT + layer * SZ_WOUT), M, DM, DM}; pg8::StaticOrder S; S.init(M, DM, G, bx, GEMM_WGM_N4096);
            pg8::EpiBf16<0> E{(bf16*)(ws + WS_Y), DM, nullptr};
            pg8::gemm_phase<pg8::EpiBf16<0>, pg8::StaticOrder, true, true, false, true>(ldsl + RING_OFF, g, S, E);
            }
            if (BOTH(pb + 4)) GRID_BAR();
        }
        if (PH_ON(6) && IN(pb + 5)) {
            PH_REP(6) {
            ArgsP ap = fresh_args(); unsigned char* ws = ap->ws;
            const float* gpost = ap->in[11] + layer * DM; const bf16* Y = (const bf16*)(ws + WS_Y); bf16* XB = (bf16*)(ws + WS_HN); float* RS = (float*)(ws + WS_RS); signed char* XQ = (signed char*)(ws + WS_XQ); float* RF = (float*)(ws + WS_RF);
            unsigned* RMAX = (unsigned*)(ws + WS_RMAX);
            { const int ln = FRESH_LANE();
              for (int m = gw; m < M; m += NGW) { resid_row<false, false, true>(Y + (size_t)m * DM, XB + (size_t)m * DM, nullptr, XB + (size_t)m * DM, RS + m, gpost, EPS, ln, XQ + (size_t)m * DM, RF + m); if (ln == 0) RMAX[m] = 0u; } }
            }
            if (BOTH(pb + 5)) GRID_BAR();
        }
        if (PH_ON(7) && IN(pb + 6)) {
            PH_REP(7) {
            ArgsP ap = fresh_args(); unsigned char* ws = ap->ws;
            pg8::Gemm g{(const bf16*)(ws + WS_XQ), (const bf16*)(ws + WS_WUP + layer * SZ_WUP), M, FF, DM / 2}; pg8::StaticOrder S; S.init(M, FF, G, bx);
            pg8::EpiI8H E{(bf16*)(ws + WS_H), FF, (const unsigned*)(ws + WS_CMAX) + layer * FF, ((I8D >> layer) & 1) ? (unsigned*)(ws + WS_RMAX) : nullptr};
            pg8::gemm_phase<pg8::EpiI8H, pg8::StaticOrder, true, true, false, true, true>(ldsl + RING_OFF, g, S, E);
            }
            if (BOTH(pb + 6)) GRID_BAR();
        }
        if (PH_ON(8) && IN(pb + 7)) {
            PH_REP(8) {
            ArgsP ap = fresh_args(); unsigned char* ws = ap->ws;
            int bxl = bx; asm volatile("" : "+s"(bxl));
            if ((I8D >> layer) & 1) {
            { const bf16* H = (const bf16*)(ws + WS_H); signed char* HQ = (signed char*)(ws + WS_HQ); const unsigned* RMAX = (const unsigned*)(ws + WS_RMAX);
              int tq = threadIdx.x; asm volatile("" : "+v"(tq));
              const int r = tq >> 3, b16 = tq & 7;
              for (int item = bx; item < (M / 256) * (FF / 128); item += G) { const int pm = item / (FF / 128), kk = item - pm * (FF / 128);
                  const bf16* src = H + (((size_t)pm * (FF / 64) + kk * 2 + (b16 >> 2)) * 256 + r) * 64 + (b16 & 3) * 16; signed char* dst = HQ + (((size_t)pm * (FF / 128) + kk) * 256 + r) * 128 + b16 * 16;
                  v4u lo[4], hi[4]; float inv[4];
#pragma unroll
                  for (int i = 0; i < 4; ++i) { lo[i] = *(const GAS v4u*)(src + i * 64 * 64); hi[i] = *(const GAS v4u*)(src + i * 64 * 64 + 8);
                      const float tm = __uint_as_float(RMAX[pm * 256 + r + 64 * i]); inv[i] = 255.0f / fmaxf(tm * tm * 1.0078125f, 1e-30f); }
#pragma unroll
                  for (int i = 0; i < 4; ++i) { float a[8], b[8]; unpack8(lo[i], a); unpack8(hi[i], b); v4u o;
                      o.x = pkq4(q8u(a[0] * inv[i]), q8u(a[1] * inv[i]), q8u(a[2] * inv[i]), q8u(a[3] * inv[i])); o.y = pkq4(q8u(a[4] * inv[i]), q8u(a[5] * inv[i]), q8u(a[6] * inv[i]), q8u(a[7] * inv[i]));
                      o.z = pkq4(q8u(b[0] * inv[i]), q8u(b[1] * inv[i]), q8u(b[2] * inv[i]), q8u(b[3] * inv[i])); o.w = pkq4(q8u(b[4] * inv[i]), q8u(b[5] * inv[i]), q8u(b[6] * inv[i]), q8u(b[7] * inv[i]));
                      *(GAS v4u*)(dst + i * 64 * 128) = o; } } }
            GRID_BAR();
            pg8::Gemm g{(const bf16*)(ws + WS_HQ), (const bf16*)(ws + WS_WDN + layer * SZ_WDN), M, DM, FF / 2}; pg8::StaticOrder S; S.init(M, DM, G, bxl, GEMM_WGM_N4096);
            pg8::EpiI8D E{(bf16*)(ws + WS_Y), DM, (const unsigned*)(ws + WS_CMAXD) + layer * DM, (const int*)(ws + WS_CSUM) + layer * DM};
            pg8::gemm_phase<pg8::EpiI8D, pg8::StaticOrder, true, true, true, true, true>(ldsl + RING_OFF, g, S, E);
            } else {
            pg8::Gemm g{(const bf16*)(ws + WS_H), (const bf16*)(ws + WS_WDN + layer * SZ_WDN), M, DM, FF}; pg8::StaticOrder S; S.init(M, DM, G, bxl, GEMM_WGM_N4096);
            pg8::EpiBf16<0> E{(bf16*)(ws + WS_Y), DM, nullptr};
            pg8::gemm_phase<pg8::EpiBf16<0>, pg8::StaticOrder, true, true, true, true>(ldsl + RING_OFF, g, S, E);
            }
            }
            if (BOTH(pb + 7)) GRID_BAR();
        }
        if (PH_ON(9) && IN(pb + 8)) {
            PH_REP(9) {
            ArgsP ap = fresh_args(); unsigned char* ws = ap->ws; float* out = ap->out;
            const float* gpost = ap->in[15] + layer * DM; const bf16* Y = (const bf16*)(ws + WS_Y); bf16* XB = (bf16*)(ws + WS_HN); float* RS = (float*)(ws + WS_RS); float* RF = (float*)(ws + WS_RF); signed char* XQ = (signed char*)(ws + WS_XQ); const unsigned* RMAX = (const unsigned*)(ws + WS_RMAX);
            { const int ln = FRESH_LANE();
              if (layer + 1 < N_LAYERS) { for (int m = gw; m < M; m += NGW) { const float r_ = RF[m], r2_ = r_ * r_; float e4_ = r2_ * r2_; if ((I8D >> layer) & 1) { const float tm_ = __uint_as_float(RMAX[m]), hs_ = fmaxf(tm_ * tm_ * 1.0078125f, 1e-30f) * (1.0f / 255.0f); e4_ *= hs_ * hs_; } if ((I8P >> (layer + 1)) & 1) resid_row<false, false, true>(Y + (size_t)m * DM, XB + (size_t)m * DM, nullptr, XB + (size_t)m * DM, RS + m, gpost, EPS / e4_, ln, XQ + (size_t)m * DM, RF + m);
                  else resid_row<false, false>(Y + (size_t)m * DM, XB + (size_t)m * DM, nullptr, XB + (size_t)m * DM, RS + m, gpost, EPS / e4_, ln); } }
              else { for (int m = gw; m < M; m += NGW) { const float r_ = RF[m], r2_ = r_ * r_; float e4_ = r2_ * r2_; if ((I8D >> layer) & 1) { const float tm_ = __uint_as_float(RMAX[m]), hs_ = fmaxf(tm_ * tm_ * 1.0078125f, 1e-30f) * (1.0f / 255.0f); e4_ *= hs_ * hs_; } resid_row<false, true>(Y + (size_t)m * DM, XB + (size_t)m * DM, out + (size_t)m * DM, nullptr, nullptr, gpost, EPS / e4_, ln); } } }
            }
            if (BOTH(pb + 8)) GRID_BAR();
        }
    }
#undef IN
#undef BOTH
#undef GRID_BAR
}

extern "C" void kernel_launch(void* const* d_in, const int* in_sizes, int n_in, void* d_out, int out_size, void* d_ws, size_t ws_size, hipStream_t stream) {
    static int grid = 0;
    if (grid == 0) {
        if (n_in != 16 || in_sizes[0] != M * DM || out_size != M * DM || ws_size < WS_END) {
            fprintf(stderr, "kernel_launch: shape mismatch n_in %d in0 %d out %d ws %zu (need %zu); nothing launched\n", n_in, n_in > 0 ? in_sizes[0] : -1, out_size, ws_size, (size_t)WS_END); grid = -1; return; }
        int dev = 0, cus = 0, per_cu = 0;
        if (hipGetDevice(&dev) != hipSuccess || hipDeviceGetAttribute(&cus, hipDeviceAttributeMultiprocessorCount, dev) != hipSuccess) { grid = -1; return; }
        if (hipFuncSetAttribute((const void*)enc_fwd, hipFuncAttributeMaxDynamicSharedMemorySize, LDS_BYTES) != hipSuccess) { fprintf(stderr, "kernel_launch: hipFuncSetAttribute failed\n"); grid = -1; return; }
        if (hipOccupancyMaxActiveBlocksPerMultiprocessor(&per_cu, (const void*)enc_fwd, NWAVES * 64, LDS_BYTES) != hipSuccess || per_cu < 1) {
            fprintf(stderr, "kernel_launch: occupancy query reports %d workgroups per CU\n", per_cu); }
        (void)hipGetLastError();
        grid = cus;
    }
    if (grid < 0) return;
    if (hipMemsetAsync((char*)d_ws + WS_CTL, 0, CTL_ZERO_BYTES, stream) != hipSuccess) return;
    Args a{};
    for (int i = 0; i < 16; ++i) a.in[i] = (const float*)d_in[i];
    a.out = (float*)d_out; a.ws = (unsigned char*)d_ws;
    for (int li = 0; li < N_LAUNCHES; ++li) {
        a.ph_lo = (N_LAUNCHES == 1) ? 0 : li; a.ph_hi = (N_LAUNCHES == 1) ? N_PHASES : li + 1; a.li = li; a.pad = 0;
        hipLaunchKernelGGL(enc_fwd, dim3(grid), dim3(NWAVES * 64), LDS_BYTES, stream, a);
        const hipError_t le = hipPeekAtLastError();
        if (le != hipSuccess) { fprintf(stderr, "kernel_launch: launch %d failed: %s\n", li, hipGetErrorName(le)); break; }
    }
}
```

```cpp
#include <hip/hip_runtime.h>
#include <cstdio>
#include <cstdint>
namespace pg8 {
#define PG8_LAS __attribute__((address_space(3)))
typedef unsigned short bf16_t;
typedef short bf16x8 __attribute__((ext_vector_type(8)));
typedef float f32x4 __attribute__((ext_vector_type(4)));
typedef unsigned u32x4 __attribute__((ext_vector_type(4)));
constexpr int BM = 256, BK = 64, HALF = 128, HTB = HALF * BK * 2  , STAGE_BYTES = 8 * HTB, NXCD = 8, WGM = 8;

__host__ __device__ __forceinline__ int lds_byte(int r, int c) { const int st = (r >> 4) * 2 + (c >> 5), rr = r & 15, cc = c & 31, ob = rr * 64 + cc * 2; return st * 1024 + (ob ^ (((ob >> 9) & 1) << 5)); }
__host__ __device__ __forceinline__ void stage_rc(int b, int& R, int& C) { const int st = b / 1024, sb = b % 1024, swz = sb ^ (((sb >> 9) & 1) << 5); R = (st >> 1) * 16 + swz / 64; C = (st & 1) * 32 + (swz % 64) / 2; }
__host__ __device__ __forceinline__ int perm32(int rho) { const int n = rho >> 4, i = rho & 15; return 8 * (i >> 2) + 4 * n + (i & 3); }

struct Unit { int pm, pn; };
struct Gemm { const bf16_t* A; const bf16_t* Bt; int M, N, K; };

struct StaticOrder {
    int nM, nN, nwg, G, c, wgm;
    __host__ __device__ void init(int M, int N, int G_, int c_, int wgm_ = WGM) { nM = M / BM; nN = N / BM; nwg = nM * nN; G = G_; c = c_; wgm = wgm_; }
    __host__ __device__ bool next(int i, Unit& u) const {
        const long L = (long)i * G + c; if (L >= nwg) return false;
        int wgid = (int)L; { const int q = nwg / NXCD, r = nwg % NXCD, xcd = wgid % NXCD, off = wgid / NXCD; wgid = (xcd < r ? xcd * (q + 1) : r * (q + 1) + (xcd - r) * q) + off; }
        const int nig = wgm * nN, gid = wgid / nig, fm = gid * wgm, gsz = (nM - fm) < wgm ? (nM - fm) : wgm;
        u.pm = fm + ((wgid % nig) % gsz); u.pn = (wgid % nig) / gsz; return true;
    }
    __device__ __forceinline__ void a_ready(const Unit&) const {}
    __device__ __forceinline__ void done(const Unit&) const {}
};

__device__ __forceinline__ unsigned cvt_pk_bf16(float lo, float hi) { unsigned r; asm volatile("v_cvt_pk_bf16_f32 %0, %1, %2" : "=v"(r) : "v"(lo), "v"(hi)); return r; }
typedef float f32x2 __attribute__((ext_vector_type(2)));
typedef int i32x4 __attribute__((ext_vector_type(4)));
template <bool I8> struct MT;
template <> struct MT<false> { typedef bf16x8 frag; typedef f32x4 acc;
    static __device__ __forceinline__ acc mma(frag a, frag b, acc c) { return __builtin_amdgcn_mfma_f32_16x16x32_bf16(a, b, c, 0, 0, 0); }
    static __device__ __forceinline__ acc zero() { return (f32x4){0.f, 0.f, 0.f, 0.f}; } };
template <> struct MT<true> { typedef i32x4 frag; typedef i32x4 acc;
    static __device__ __forceinline__ acc mma(frag a, frag b, acc c) { return __builtin_amdgcn_mfma_i32_16x16x64_i8(a, b, c, 0, 0, 0); }
    static __device__ __forceinline__ acc zero() { return (i32x4){0, 0, 0, 0}; } };
template <int ACT, bool TILED = false> struct EpiBf16 {
    static constexpr bool PERM = true, AFTER_DRAIN = false;
    bf16_t* O; int ldc; const float* rs;
    __device__ __forceinline__ void operator()(const f32x4 (&acc)[2][2][4][2], const Unit& u, int wr, int wc, int fr, int fq) const {
        const int row0 = u.pm * BM + wr * 64 + fr, col0 = u.pn * BM + wc * 32 + 8 * fq;
#pragma unroll
        for (int ai = 0; ai < 2; ++ai)
#pragma unroll
            for (int m = 0; m < 4; ++m) { const int row = row0 + ai * HALF + m * 16;
                bf16_t* rowp = TILED ? O + ((((size_t)u.pm * (ldc >> 6) + (u.pn * 4 + (wc >> 1))) * 256 + (wr * 64 + fr + ai * HALF + m * 16)) * 64 + (wc & 1) * 32 + 8 * fq)
                                     : O + (size_t)row * ldc + col0;
                const float sc = rs ? rs[row] : 1.0f;
#pragma unroll
                for (int bj = 0; bj < 2; ++bj) { f32x4 v0 = acc[ai][bj][m][0] * sc, v1 = acc[ai][bj][m][1] * sc;
                    if (ACT == 2) {
#pragma unroll
                        for (int e = 0; e < 4; ++e) { const float a = fmaxf(v0[e], 0.f), b = fmaxf(v1[e], 0.f); v0[e] = a * a; v1[e] = b * b; } }
                    u32x4 w; w.x = cvt_pk_bf16(v0[0], v0[1]); w.y = cvt_pk_bf16(v0[2], v0[3]); w.z = cvt_pk_bf16(v1[0], v1[1]); w.w = cvt_pk_bf16(v1[2], v1[3]);
                    *(u32x4*)(rowp + (TILED ? bj * 2 * 256 * 64 : bj * HALF)) = w; } }
    }
};
struct EpiF32 {
    static constexpr bool PERM = false, AFTER_DRAIN = false;
    float* C; int ldc;
    __device__ __forceinline__ void operator()(const f32x4 (&acc)[2][2][4][2], const Unit& u, int wr, int wc, int fr, int fq) const {
        const int row0 = u.pm * BM + wr * 64 + fr, col0 = u.pn * BM + wc * 32 + 4 * fq;
#pragma unroll
        for (int ai = 0; ai < 2; ++ai)
#pragma unroll
            for (int m = 0; m < 4; ++m) { float* rowp = C + (size_t)(row0 + ai * HALF + m * 16) * ldc + col0;
#pragma unroll
                for (int bj = 0; bj < 2; ++bj)
#pragma unroll
                    for (int n = 0; n < 2; ++n) *(f32x4*)(rowp + bj * HALF + n * 16) = acc[ai][bj][m][n]; }
    }
};
struct EpiI8H {
    static constexpr bool PERM = true, AFTER_DRAIN = false;
    bf16_t* O; int ldc; const unsigned* cmax; unsigned* rmax;
    __device__ __forceinline__ void operator()(const i32x4 (&acc)[2][2][4][2], const Unit& u, int wr, int wc, int fr, int fq) const {
        asm volatile("" : "+v"(fr));
        const int col0 = u.pn * BM + wc * 32 + 8 * fq, lane = fr + 16 * fq;
        float cs[2][8];
#pragma unroll
        for (int bj = 0; bj < 2; ++bj) { const u32x4 cb0 = *(const u32x4*)(cmax + col0 + bj * HALF), cb1 = *(const u32x4*)(cmax + col0 + bj * HALF + 4);
#pragma unroll
            for (int e = 0; e < 4; ++e) { cs[bj][e] = __uint_as_float(cb0[e]) * (1.0f / 127.0f); cs[bj][4 + e] = __uint_as_float(cb1[e]) * (1.0f / 127.0f); } }
#pragma unroll
        for (int ai = 0; ai < 2; ++ai)
#pragma unroll
            for (int m = 0; m < 4; ++m) { const int rl = wr * 64 + fr + ai * HALF + m * 16;
                bf16_t* rowp = O + ((((size_t)u.pm * (ldc >> 6) + (u.pn * 4 + (wc >> 1))) * 256 + rl) * 64 + (wc & 1) * 32 + 8 * fq);
                float tm = 0.f;
#pragma unroll
                for (int bj = 0; bj < 2; ++bj) { float v[8];
#pragma unroll
                    for (int e = 0; e < 4; ++e) { const float a = fmaxf((float)acc[ai][bj][m][0][e] * cs[bj][e], 0.f), b = fmaxf((float)acc[ai][bj][m][1][e] * cs[bj][4 + e], 0.f);
                        tm = fmaxf(tm, fmaxf(a, b)); v[e] = a * a; v[4 + e] = b * b; }
                    u32x4 w; w.x = cvt_pk_bf16(v[0], v[1]); w.y = cvt_pk_bf16(v[2], v[3]); w.z = cvt_pk_bf16(v[4], v[5]); w.w = cvt_pk_bf16(v[6], v[7]);
                    *(u32x4*)(rowp + bj * 2 * 256 * 64) = w; }
                if (rmax) {
                    tm = fmaxf(tm, __int_as_float(__builtin_amdgcn_ds_bpermute((lane ^ 16) << 2, __float_as_int(tm))));
                    tm = fmaxf(tm, __int_as_float(__builtin_amdgcn_ds_bpermute((lane ^ 32) << 2, __float_as_int(tm))));
                    if (fq == 0) (void)__hip_atomic_fetch_max(rmax + u.pm * BM + rl, __float_as_uint(tm), __ATOMIC_RELAXED, __HIP_MEMORY_SCOPE_AGENT); } }
    }
};
struct EpiI8D {
    static constexpr bool PERM = true, AFTER_DRAIN = false;
    bf16_t* O; int ldc; const unsigned* cmax; const int* csum;
    __device__ __forceinline__ void operator()(const i32x4 (&acc)[2][2][4][2], const Unit& u, int wr, int wc, int fr, int fq) const {
        const int row0 = u.pm * BM + wr * 64 + fr, col0 = u.pn * BM + wc * 32 + 8 * fq;
#pragma unroll
        for (int bj = 0; bj < 2; ++bj) {
            const u32x4 cb0 = *(const u32x4*)(cmax + col0 + bj * HALF), cb1 = *(const u32x4*)(cmax + col0 + bj * HALF + 4);
            const i32x4 k0 = *(const i32x4*)(csum + col0 + bj * HALF) * 128, k1 = *(const i32x4*)(csum + col0 + bj * HALF + 4) * 128;
#pragma unroll
            for (int ai = 0; ai < 2; ++ai)
#pragma unroll
                for (int m = 0; m < 4; ++m) { const int row = row0 + ai * HALF + m * 16; float v[8];
#pragma unroll
                    for (int e = 0; e < 4; ++e) { v[e] = (float)(acc[ai][bj][m][0][e] + k0[e]) * (__uint_as_float(cb0[e]) * (1.0f / 127.0f)); v[4 + e] = (float)(acc[ai][bj][m][1][e] + k1[e]) * (__uint_as_float(cb1[e]) * (1.0f / 127.0f)); }
                    u32x4 w; w.x = cvt_pk_bf16(v[0], v[1]); w.y = cvt_pk_bf16(v[2], v[3]); w.z = cvt_pk_bf16(v[4], v[5]); w.w = cvt_pk_bf16(v[6], v[7]);
                    *(u32x4*)(O + (size_t)row * ldc + col0 + bj * HALF) = w; } }
    }
};
struct EpiI8P {
    static constexpr bool PERM = true, AFTER_DRAIN = false;
    bf16_t* O; int ldc; const float* rf; const unsigned* cmax;
    __device__ __forceinline__ void operator()(const i32x4 (&acc)[2][2][4][2], const Unit& u, int wr, int wc, int fr, int fq) const {
        const int row0 = u.pm * BM + wr * 64 + fr, col0 = u.pn * BM + wc * 32 + 8 * fq;
#pragma unroll
        for (int ai = 0; ai < 2; ++ai)
#pragma unroll
            for (int m = 0; m < 4; ++m) { const int row = row0 + ai * HALF + m * 16; const float sc = rf[row] * (1.0f / 127.0f);
#pragma unroll
                for (int bj = 0; bj < 2; ++bj) {
                    const u32x4 cb0 = *(const u32x4*)(cmax + col0 + bj * HALF), cb1 = *(const u32x4*)(cmax + col0 + bj * HALF + 4);
                    float v[8];
#pragma unroll
                    for (int e = 0; e < 4; ++e) { v[e] = (float)acc[ai][bj][m][0][e] * sc * __uint_as_float(cb0[e]); v[4 + e] = (float)acc[ai][bj][m][1][e] * sc * __uint_as_float(cb1[e]); }
                    u32x4 w; w.x = cvt_pk_bf16(v[0], v[1]); w.y = cvt_pk_bf16(v[2], v[3]); w.z = cvt_pk_bf16(v[4], v[5]); w.w = cvt_pk_bf16(v[6], v[7]);
                    *(u32x4*)(O + (size_t)row * ldc + col0 + bj * HALF) = w; } }
    }
};

template <class Epi, class Sched, bool ALIGN_EPI = false, bool SP2 = false, bool TILED_A = false, bool TILED_B = false, bool I8 = false>
__device__ __forceinline__ void gemm_phase(PG8_LAS unsigned char* lds, const Gemm g, const Sched& S, const Epi& E) {
    int tid_ = threadIdx.x; asm volatile("" : "+v"(tid_));
    const int tid = tid_, wid = __builtin_amdgcn_readfirstlane(tid >> 6), lane = tid & 63, wr = wid >> 2, wc = wid & 3, fr = lane & 15, fq = lane >> 4;
    const int K = g.K, nt = K / BK;
    unsigned voffA[2], voffB[2];
#pragma unroll
    for (int i = 0; i < 2; ++i) { int R, C; stage_rc(tid * 16 + i * 8192, R, C); const int Rb = Epi::PERM ? ((R & ~31) + perm32(R & 31)) : R;
        voffA[i] = (unsigned)(R * (TILED_A ? BK : K) + C) * 2u; voffB[i] = (unsigned)(Rb * (TILED_B ? BK : K) + C) * 2u; }
    const size_t kstepA = TILED_A ? (size_t)(BM * BK * 2) : (size_t)(BK * 2), kstepB = TILED_B ? (size_t)(BM * BK * 2) : (size_t)(BK * 2);
    const size_t hstepA = TILED_A ? (size_t)(HALF * BK * 2) : (size_t)HALF * K * 2, hstepB = TILED_B ? (size_t)(HALF * BK * 2) : (size_t)HALF * K * 2;
    const size_t tstep = (size_t)BM * K * 2;
    const unsigned ldsw = (unsigned)wid * 1024u;
    const int aoff = lds_byte(wr * 64 + fr, fq * 8), boff = lds_byte(wc * 32 + fr, fq * 8);
#define PG8_SA(b, h) (((b) * 2 + (h)) * HTB)
#define PG8_SB(b, h) ((4 + (b) * 2 + (h)) * HTB)
#define PG8_STAGE(bufoff, gbase, voff) do { _Pragma("unroll") for (int _i = 0; _i < 2; ++_i) \
        __builtin_amdgcn_global_load_lds((const unsigned*)((const char*)(gbase) + (voff)[_i]), (PG8_LAS unsigned*)(lds + (bufoff) + ldsw + _i * 8192), 16, 0, 0); } while (0)
#define PG8_LDA(dst, b, h) do { _Pragma("unroll") for (int m = 0; m < 4; ++m) _Pragma("unroll") for (int k = 0; k < 2; ++k) dst[m][k] = *(const PG8_LAS frag_t*)(lds + PG8_SA(b, h) + aoff + m * 2048 + k * 1024); } while (0)
#define PG8_LDB(dst, b, h) do { _Pragma("unroll") for (int n = 0; n < 2; ++n) _Pragma("unroll") for (int k = 0; k < 2; ++k) dst[n][k] = *(const PG8_LAS frag_t*)(lds + PG8_SB(b, h) + boff + n * 2048 + k * 1024); } while (0)
#define PG8_MMA(ai, bj, At, Bt) do { __builtin_amdgcn_s_setprio(1); _Pragma("unroll") for (int m = 0; m < 4; ++m) _Pragma("unroll") for (int n = 0; n < 2; ++n) _Pragma("unroll") for (int k = 0; k < 2; ++k) \
        acc[ai][bj][m][n] = MT<I8>::mma(Bt[n][k], At[m][k], acc[ai][bj][m][n]); __builtin_amdgcn_s_setprio(0); } while (0)
#define PG8_WAIT_V(n) asm volatile("s_waitcnt vmcnt(" #n ")" ::: "memory")
#define PG8_WAIT_L(n) asm volatile("s_waitcnt lgkmcnt(" #n ")" ::: "memory")
#define PG8_BAR __builtin_amdgcn_s_barrier()
#define PG8_SCHED __builtin_amdgcn_sched_barrier(0)
    Unit cur, nxt; int ui = 0;
    if (!S.next(0, cur)) return;
    typedef typename MT<I8>::frag frag_t; typedef typename MT<I8>::acc acc_t;
    acc_t acc[2][2][4][2];
#pragma unroll
    for (int a = 0; a < 2; ++a)
#pragma unroll
        for (int b = 0; b < 2; ++b)
#pragma unroll
            for (int m = 0; m < 4; ++m)
#pragma unroll
                for (int n = 0; n < 2; ++n) acc[a][b][m][n] = MT<I8>::zero();
    frag_t At[4][2], B0[2][2], B1[2][2];
    const char* cA = (const char*)g.A + (size_t)cur.pm * tstep; const char* cB = (const char*)g.Bt + (size_t)cur.pn * tstep;
    S.a_ready(cur);
    if constexpr (SP2) {
        PG8_STAGE(PG8_SB(0, 0), cB, voffB); PG8_STAGE(PG8_SB(0, 1), cB + hstepB, voffB); PG8_STAGE(PG8_SA(0, 0), cA, voffA); PG8_STAGE(PG8_SA(0, 1), cA + hstepA, voffA);
        if (wr == 1) PG8_BAR;
        PG8_WAIT_V(2); PG8_BAR;
        PG8_STAGE(PG8_SB(1, 0), cB + kstepB, voffB); PG8_STAGE(PG8_SA(1, 0), cA + kstepA, voffA); PG8_STAGE(PG8_SB(1, 1), cB + hstepB + kstepB, voffB);
        PG8_WAIT_V(6); PG8_BAR;
    } else {
        PG8_STAGE(PG8_SB(0, 0), cB, voffB); PG8_STAGE(PG8_SA(0, 0), cA, voffA); PG8_STAGE(PG8_SB(0, 1), cB + hstepB, voffB); PG8_STAGE(PG8_SA(0, 1), cA + hstepA, voffA);
        if (wr == 1) PG8_BAR;
        PG8_WAIT_V(4); PG8_BAR;
        PG8_STAGE(PG8_SB(1, 0), cB + kstepB, voffB); PG8_STAGE(PG8_SA(1, 0), cA + kstepA, voffA); PG8_STAGE(PG8_SB(1, 1), cB + hstepB + kstepB, voffB);
        PG8_WAIT_V(6); PG8_BAR;
    }
    for (;;) {
        const bool has_next = S.next(ui + 1, nxt);
        const char* nA = has_next ? (const char*)g.A + (size_t)nxt.pm * tstep : cA; const char* nB = has_next ? (const char*)g.Bt + (size_t)nxt.pn * tstep : cB;
        for (int t = 0; t < nt; t += 2) {
            const bool last = (t == nt - 2);
            const char* a1 = cA + (size_t)(t + 1) * kstepA;
            const char* a2 = last ? nA : cA + (size_t)(t + 2) * kstepA; const char* b2 = last ? nB : cB + (size_t)(t + 2) * kstepB;
            const char* a3 = a2 + kstepA; const char* b3 = b2 + kstepB;
            if (last && has_next) S.a_ready(nxt);
            if constexpr (SP2) {
            PG8_LDB(B0, 0, 0); PG8_LDB(B1, 0, 1); PG8_SCHED; PG8_LDA(At, 0, 0); PG8_STAGE(PG8_SA(1, 1), a1 + hstepA, voffA);
            PG8_WAIT_V(8); PG8_WAIT_L(0); PG8_BAR; PG8_MMA(0, 0, At, B0); PG8_MMA(0, 1, At, B1); PG8_BAR; PG8_SCHED;
            PG8_LDA(At, 0, 1); PG8_STAGE(PG8_SB(0, 0), b2, voffB); PG8_STAGE(PG8_SB(0, 1), b2 + hstepB, voffB); PG8_STAGE(PG8_SA(0, 0), a2, voffA);
            PG8_WAIT_V(8); PG8_WAIT_L(0); PG8_BAR; PG8_MMA(1, 0, At, B0); PG8_MMA(1, 1, At, B1); PG8_BAR; PG8_SCHED;
            PG8_LDB(B0, 1, 0); PG8_LDB(B1, 1, 1); PG8_SCHED; PG8_LDA(At, 1, 0); PG8_STAGE(PG8_SA(0, 1), a2 + hstepA, voffA);
            PG8_WAIT_V(8); PG8_WAIT_L(0); PG8_BAR; PG8_MMA(0, 0, At, B0); PG8_MMA(0, 1, At, B1); PG8_BAR; PG8_SCHED;
            PG8_LDA(At, 1, 1); PG8_STAGE(PG8_SB(1, 0), b3, voffB); PG8_STAGE(PG8_SB(1, 1), b3 + hstepB, voffB); PG8_STAGE(PG8_SA(1, 0), a3, voffA);
            PG8_WAIT_V(8); PG8_WAIT_L(0); PG8_BAR; PG8_MMA(1, 0, At, B0); PG8_MMA(1, 1, At, B1); PG8_BAR; PG8_SCHED;
            } else {
            PG8_LDB(B0, 0, 0); PG8_SCHED; PG8_LDA(At, 0, 0); PG8_STAGE(PG8_SA(1, 1), a1 + hstepA, voffA);
            PG8_WAIT_L(8); PG8_BAR; PG8_WAIT_L(0); PG8_MMA(0, 0, At, B0); PG8_BAR; PG8_SCHED;
            PG8_LDB(B1, 0, 1); PG8_STAGE(PG8_SB(0, 0), b2, voffB);
            PG8_BAR; PG8_WAIT_L(0); PG8_MMA(0, 1, At, B1); PG8_BAR;
            PG8_LDA(At, 0, 1); PG8_STAGE(PG8_SA(0, 0), a2, voffA);
            PG8_BAR; PG8_WAIT_L(0); PG8_MMA(1, 0, At, B0); PG8_BAR; PG8_SCHED;
            PG8_STAGE(PG8_SB(0, 1), b2 + hstepB, voffB);
            PG8_WAIT_V(6); PG8_BAR; PG8_MMA(1, 1, At, B1); PG8_BAR;
            PG8_LDB(B0, 1, 0); PG8_SCHED; PG8_LDA(At, 1, 0); PG8_STAGE(PG8_SA(0, 1), a2 + hstepA, voffA);
            PG8_WAIT_L(8); PG8_BAR; PG8_WAIT_L(0); PG8_MMA(0, 0, At, B0); PG8_BAR; PG8_SCHED;
            PG8_LDB(B1, 1, 1); PG8_STAGE(PG8_SB(1, 0), b3, voffB);
            PG8_BAR; PG8_WAIT_L(0); PG8_MMA(0, 1, At, B1); PG8_BAR;
            PG8_LDA(At, 1, 1); PG8_STAGE(PG8_SA(1, 0), a3, voffA);
            PG8_BAR; PG8_WAIT_L(0); PG8_MMA(1, 0, At, B0); PG8_BAR; PG8_SCHED;
            PG8_STAGE(PG8_SB(1, 1), b3 + hstepB, voffB);
            PG8_WAIT_V(6); PG8_BAR; PG8_MMA(1, 1, At, B1); PG8_BAR;
            }
        }
        if constexpr (ALIGN_EPI) { if (wr == 0) PG8_BAR; }
        if constexpr (!Epi::AFTER_DRAIN) { E(acc, cur, wr, wc, fr, fq); S.done(cur); }
        if (!has_next) break;
#pragma unroll
        for (int a = 0; a < 2; ++a)
#pragma unroll
            for (int b = 0; b < 2; ++b)
#pragma unroll
                for (int m = 0; m < 4; ++m)
#pragma unroll
                    for (int n = 0; n < 2; ++n) acc[a][b][m][n] = MT<I8>::zero();
        cur = nxt; cA = nA; cB = nB; ++ui;
        if constexpr (ALIGN_EPI) { if (wr == 1) PG8_BAR; }
    }
    PG8_WAIT_V(0);
    if constexpr (!ALIGN_EPI) { if (wr == 0) PG8_BAR; }
    PG8_BAR;
    if constexpr (Epi::AFTER_DRAIN) { E.fused(acc, cur, wr, wc, fr, fq, lds, wid, lane); S.done(cur); }
#undef PG8_SA
#undef PG8_SB
#undef PG8_STAGE
#undef PG8_LDA
#undef PG8_LDB
#undef PG8_MMA
#undef PG8_WAIT_V
#undef PG8_WAIT_L
#undef PG8_BAR
#undef PG8_SCHED
}
}
namespace att {
typedef unsigned short bf16_t;
using bf16x8 = __attribute__((ext_vector_type(8))) short;
using s16x4  = __attribute__((ext_vector_type(4))) short;
using f32x16 = __attribute__((ext_vector_type(16))) float;
using u32x4  = __attribute__((ext_vector_type(4))) unsigned;
typedef float f32x2a __attribute__((ext_vector_type(2)));
typedef float f32x4a __attribute__((ext_vector_type(4)));
constexpr int   D = 128, NW = 8, QBLK = 32, KVBLK = 64;
constexpr float SCALE = 0.088388347648318440f;
constexpr float THR = 8.f;
constexpr int SEQ = 8192, INW = 9216;
constexpr int LDQ = INW, LDKK = 512, LDV = INW, LDO = 2048;
constexpr size_t SHM_V = KVBLK * D * 2, SHM_K = KVBLK * D * 2, SHM_ATTN = 2 * SHM_V + 2 * SHM_K + NW * 64 * 4;
#define KSWZ(row, colB) ((row) * 256 + ((colB) ^ (((row) & 7) << 4)))
#define SBAR() __builtin_amdgcn_sched_barrier(0)
__device__ __forceinline__ int crow(int r, int hi) { return (r & 3) + 8 * (r >> 2) + 4 * hi; }
typedef float f32x2_t __attribute__((ext_vector_type(2))); typedef __bf16 bf16x2_t __attribute__((ext_vector_type(2)));
__device__ __forceinline__ unsigned cvtpk(float lo, float hi) { f32x2_t v = {lo, hi}; bf16x2_t b = __builtin_convertvector(v, bf16x2_t); return __builtin_bit_cast(unsigned, b); }
__device__ __forceinline__ float bf2f(short v) { return __uint_as_float(((unsigned)(unsigned short)v) << 16); }
__device__ __forceinline__ bf16x8 ld8(const bf16_t* p) { return *reinterpret_cast<const bf16x8*>(p); }

__device__ __forceinline__ void partialSM(f32x16& p0, f32x16& p1, float& m_reg, float& mn, float& alpha) {
  constexpr float C = SCALE * 1.4426950408889634f;
  float pmax = p0[0]; for (int r = 1; r < 16; ++r) pmax = fmaxf(pmax, p0[r]); for (int r = 0; r < 16; ++r) pmax = fmaxf(pmax, p1[r]);
  { auto rr = __builtin_amdgcn_permlane32_swap(__float_as_uint(pmax), __float_as_uint(pmax), false, false);
    pmax = fmaxf(__uint_as_float(rr[0]), __uint_as_float(rr[1])); }
  if (__builtin_expect(__all(pmax - m_reg <= THR / SCALE), 1)) { mn = m_reg; alpha = 1.f; }
  else { mn = fmaxf(m_reg, pmax); alpha = __builtin_amdgcn_exp2f((m_reg - mn) * C); m_reg = mn; }
  float mnC = -mn * C;
  for (int r = 0; r < 16; ++r) p0[r] = fmaf(p0[r], C, mnC); for (int r = 0; r < 16; ++r) p1[r] = fmaf(p1[r], C, mnC);
  for (int r = 0; r < 16; ++r) p0[r] = __builtin_amdgcn_exp2f(p0[r]);
}
#define ATT_PK4(P, BASE, OUT) do { unsigned a0 = cvtpk(P[BASE + 0], P[BASE + 1]), a1 = cvtpk(P[BASE + 2], P[BASE + 3]);   \
    unsigned b0 = cvtpk(P[BASE + 4], P[BASE + 5]), b1 = cvtpk(P[BASE + 6], P[BASE + 7]);                              \
    auto r0 = __builtin_amdgcn_permlane32_swap(a0, b0, false, false); auto r1 = __builtin_amdgcn_permlane32_swap(a1, b1, false, false); \
    u32x4 w = {r0[0], r1[0], r0[1], r1[1]}; OUT = *reinterpret_cast<bf16x8*>(&w); } while (0)
__device__ __forceinline__ void finishSM(f32x16& p0, f32x16& p1, float alpha, float& l_reg, bf16x8& pa0, bf16x8& pa1, bf16x8& pa2, bf16x8& pa3) {
  for (int r = 0; r < 16; ++r) p1[r] = __builtin_amdgcn_exp2f(p1[r]);
  float ps = 0; for (int r = 0; r < 16; ++r) ps += p0[r]; for (int r = 0; r < 16; ++r) ps += p1[r];
  { auto rr = __builtin_amdgcn_permlane32_swap(__float_as_uint(ps), __float_as_uint(ps), false, false);
    ps = __uint_as_float(rr[0]) + __uint_as_float(rr[1]); }
  l_reg = l_reg * alpha + ps;
  ATT_PK4(p0, 0, pa0); ATT_PK4(p0, 8, pa1); ATT_PK4(p1, 0, pa2); ATT_PK4(p1, 8, pa3);
}
__device__ __forceinline__ void qkt(f32x16& p0, f32x16& p1, const bf16_t* Ks, const bf16x8* qr, int r32, int hi) {
  p0 = f32x16{}; p1 = f32x16{};
  for (int d0 = 0; d0 < 8; ++d0) { int cb = (d0 * 16 + hi * 8) * 2;
    bf16x8 b0 = *reinterpret_cast<const bf16x8*>((const char*)Ks + KSWZ(r32, cb));
    bf16x8 b1 = *reinterpret_cast<const bf16x8*>((const char*)Ks + KSWZ(32 + r32, cb));
    p0 = __builtin_amdgcn_mfma_f32_32x32x16_bf16(b0, qr[d0], p0, 0, 0, 0);
    p1 = __builtin_amdgcn_mfma_f32_32x32x16_bf16(b1, qr[d0], p1, 0, 0, 0); }
}
__device__ __forceinline__ int v_st(int k, int c) { const int kk = (k & ~0xC) | ((k & 4) << 1) | ((k & 8) >> 1); return ((kk >> 3) * 4 + (c >> 5)) * 512 + ((kk & 7) * 32 + (c & 31)) * 2; }
__device__ __forceinline__ int v_rd_base(int lane) { return ((lane & 3) << 3) | (((lane >> 2) & 3) << 6) | (((lane >> 4) & 1) << 5) | (((lane >> 5) & 1) << 8); }
constexpr int v_rd_off(int d0, int ks, int half) { return d0 * 512 + ks * 4096 + half * 2048; }
template <int OFF> __device__ __forceinline__ s16x4 tr_read(int vb) {
  s16x4 r; asm volatile("ds_read_b64_tr_b16 %0, %1 offset:%2" : "=&v"(r) : "v"(vb), "i"(OFF) : "memory"); return r;
}
#define ATT_PK(L, H) (bf16x8){L[0], L[1], L[2], L[3], H[0], H[1], H[2], H[3]}
template <int D0> __device__ __forceinline__ void pv_one(f32x16& od, int vb, bf16x8 pa0, bf16x8 pa1, bf16x8 pa2, bf16x8 pa3) {
  const s16x4 l0 = tr_read<v_rd_off(D0, 0, 0)>(vb), h0 = tr_read<v_rd_off(D0, 0, 1)>(vb), l1 = tr_read<v_rd_off(D0, 1, 0)>(vb), h1 = tr_read<v_rd_off(D0, 1, 1)>(vb);
  const s16x4 l2 = tr_read<v_rd_off(D0, 2, 0)>(vb), h2 = tr_read<v_rd_off(D0, 2, 1)>(vb), l3 = tr_read<v_rd_off(D0, 3, 0)>(vb), h3 = tr_read<v_rd_off(D0, 3, 1)>(vb);
  asm volatile("s_waitcnt lgkmcnt(0)" ::: "memory"); SBAR();
  od = __builtin_amdgcn_mfma_f32_32x32x16_bf16(pa0, ATT_PK(l0, h0), od, 0, 0, 0);
  od = __builtin_amdgcn_mfma_f32_32x32x16_bf16(pa1, ATT_PK(l1, h1), od, 0, 0, 0);
  od = __builtin_amdgcn_mfma_f32_32x32x16_bf16(pa2, ATT_PK(l2, h2), od, 0, 0, 0);
  od = __builtin_amdgcn_mfma_f32_32x32x16_bf16(pa3, ATT_PK(l3, h3), od, 0, 0, 0);
}
__device__ __forceinline__ void pv_d0(f32x16* o, int vb, bf16x8 pa0, bf16x8 pa1, bf16x8 pa2, bf16x8 pa3) {
  pv_one<0>(o[0], vb, pa0, pa1, pa2, pa3); pv_one<1>(o[1], vb, pa0, pa1, pa2, pa3); pv_one<2>(o[2], vb, pa0, pa1, pa2, pa3); pv_one<3>(o[3], vb, pa0, pa1, pa2, pa3);
}

template <bool FAST> __device__ __forceinline__ void psm(f32x16& p0, f32x16& p1, float& m_reg, float& mn, float& alpha) {
  if constexpr (FAST) { alpha = 1.f; for (int r = 0; r < 16; ++r) p0[r] = __builtin_amdgcn_exp2f(p0[r]); }
  else partialSM(p0, p1, m_reg, mn, alpha);
}
template <bool FAST> __device__ __forceinline__ void fsm(f32x16& p0, f32x16& p1, float alpha, float& l_reg, bf16x8& pa0, bf16x8& pa1, bf16x8& pa2, bf16x8& pa3) {
  if constexpr (FAST) finishSM(p0, p1, 1.f, l_reg, pa0, pa1, pa2, pa3); else finishSM(p0, p1, alpha, l_reg, pa0, pa1, pa2, pa3);
}
template <bool FAST> __device__ __forceinline__ void attn_dense_body(const bf16_t* __restrict__ Qb, const bf16_t* __restrict__ Kh, const bf16_t* __restrict__ Vh,
                                                bf16_t* __restrict__ Ob, int t0, const float* __restrict__ qg, const f32x2a* __restrict__ rtab, char* lds) {
  int tid_ = threadIdx.x; asm volatile("" : "+v"(tid_));
  const int tid = tid_, wid = __builtin_amdgcn_readfirstlane(tid >> 6), lane = tid & 63, r32 = lane & 31, hi = lane >> 5;
  bf16_t* V_lds = (bf16_t*)lds; bf16_t* K_lds = (bf16_t*)(lds + 2 * SHM_V);
  float* ws = (float*)(lds + 2 * SHM_V + 2 * SHM_K) + wid * 64; float* li_l = ws; float* al_l = ws + 32;
  float m_reg = -1e30f, l_reg = 0; f32x16 o[4] = {}; bf16x8 qr[8];
  {
    const int prow = tid >> 4, chunk = tid & 15, i0 = (chunk & 3) * 8; const bool second = (chunk & 4) != 0;
    float gq[8];
#pragma unroll
    for (int e = 0; e < 8; ++e) gq[e] = qg[chunk * 8 + e];
#pragma unroll 2
    for (int p = 0; p < 8; ++p) { const int row = p * 32 + prow;
      const bf16x8 raw = ld8(Qb + (long)row * LDQ + chunk * 8);
      float v[8]; float ss = 0.f;
#pragma unroll
      for (int e = 0; e < 8; ++e) { v[e] = bf2f(raw[e]); ss += v[e] * v[e]; }
      ss += __shfl_xor(ss, 1); ss += __shfl_xor(ss, 2); ss += __shfl_xor(ss, 4); ss += __shfl_xor(ss, 8);
      const float rstd = (FAST ? SCALE * 1.4426950408889634f : 1.0f) / sqrtf(ss * (1.0f / 128.0f) + 1e-6f);
      const int t = t0 + row, pos = (chunk < 8) ? (t >> 6) : (t & 63);
      float o8[8];
#pragma unroll
      for (int e = 0; e < 8; ++e) v[e] *= rstd * gq[e];
#pragma unroll
      for (int e = 0; e < 8; ++e) { const float pr = __shfl_xor(v[e], 4); const f32x2a cs = rtab[pos * 32 + i0 + e];
        o8[e] = second ? (v[e] * cs.x + pr * cs.y) : (v[e] * cs.x - pr * cs.y); }
      u32x4 w = {cvtpk(o8[0], o8[1]), cvtpk(o8[2], o8[3]), cvtpk(o8[4], o8[5]), cvtpk(o8[6], o8[7])};
      *(u32x4*)(lds + KSWZ(row, chunk * 16)) = w; }
    __syncthreads();
#pragma unroll
    for (int d0 = 0; d0 < 8; ++d0) qr[d0] = *reinterpret_cast<const bf16x8*>(lds + KSWZ(wid * QBLK + r32, (d0 * 16 + hi * 8) * 2));
    __syncthreads();
  }
  const int sr = tid >> 4, sc = (tid & 15) * 8, vst0 = v_st(sr, sc), vst1 = v_st(32 + sr, sc);
  const int vb0 = (int)(uintptr_t)V_lds + v_rd_base(lane);
  struct { bf16x8 vs0, vs1, ks0, ks1; } sr_[2];
  const unsigned voff = (unsigned)(sr * LDV + sc) * 2u, koff = (unsigned)(sr * LDKK + sc) * 2u;
#define SLOAD(i, k0) do { const char* vb_ = (const char*)Vh + (size_t)(k0) * (LDV * 2); const char* kb_ = (const char*)Kh + (size_t)(k0) * (LDKK * 2); \
    sr_[i].vs0 = *(const bf16x8*)(vb_ + voff); sr_[i].vs1 = *(const bf16x8*)(vb_ + 32 * LDV * 2 + voff); \
    sr_[i].ks0 = *(const bf16x8*)(kb_ + koff); sr_[i].ks1 = *(const bf16x8*)(kb_ + 32 * LDKK * 2 + koff); } while (0)
#define SWRITE(b, i) do { *(bf16x8*)((char*)V_lds + (b) * SHM_V + vst0) = sr_[i].vs0;          \
    *(bf16x8*)((char*)V_lds + (b) * SHM_V + vst1) = sr_[i].vs1; int kc = sc * 2;               \
    *(bf16x8*)((char*)K_lds + (b) * SHM_K + KSWZ(sr, kc)) = sr_[i].ks0;                       \
    *(bf16x8*)((char*)K_lds + (b) * SHM_K + KSWZ(32 + sr, kc)) = sr_[i].ks1; } while (0)
#define SWAIT() asm volatile("s_waitcnt vmcnt(4)" ::: "memory")
#define RESC(a) do { if (__any((a) < 1.f)) { if (hi == 0) al_l[r32] = (a); asm volatile("s_waitcnt lgkmcnt(0)" ::: "memory"); \
    for (int d = 0; d < 4; ++d) for (int r = 0; r < 16; ++r) o[d][r] *= al_l[crow(r, hi)]; } } while (0)
  f32x16 pA0, pA1, pB0, pB1; float mnA, mnB, alA, alB; bf16x8 pa0, pa1, pa2, pa3; constexpr int NT = SEQ / KVBLK;
  constexpr int SE = 0, SO = 1;
  SLOAD(SE, 0); asm volatile("s_waitcnt vmcnt(0)" ::: "memory"); SWRITE(0, SE); __syncthreads();
  qkt(pA0, pA1, K_lds, qr, r32, hi); psm<FAST>(pA0, pA1, m_reg, mnA, alA);
  SLOAD(SO, KVBLK); SLOAD(SE, 2 * KVBLK);
  SWAIT(); SWRITE(1, SO); __syncthreads();
  for (int j = 1; j + 1 < NT; j += 2) {
    SBAR(); qkt(pB0, pB1, (bf16_t*)((char*)K_lds + SHM_K), qr, r32, hi);
    fsm<FAST>(pA0, pA1, alA, l_reg, pa0, pa1, pa2, pa3); SBAR();
    SLOAD(SO, (j + 2) * KVBLK); SBAR();
    pv_d0(o, vb0, pa0, pa1, pa2, pa3); psm<FAST>(pB0, pB1, m_reg, mnB, alB);
    __syncthreads(); SWAIT(); SWRITE(0, SE);
    if constexpr (!FAST) RESC(alB); __syncthreads();
    SBAR(); qkt(pA0, pA1, K_lds, qr, r32, hi);
    fsm<FAST>(pB0, pB1, alB, l_reg, pa0, pa1, pa2, pa3); SBAR();
    if (j + 3 < NT) SLOAD(SE, (j + 3) * KVBLK); SBAR();
    pv_d0(o, vb0 + (int)SHM_V, pa0, pa1, pa2, pa3); psm<FAST>(pA0, pA1, m_reg, mnA, alA);
    __syncthreads(); SWAIT(); SWRITE(1, SO);
    if constexpr (!FAST) RESC(alA); __syncthreads();
  }
  SBAR(); qkt(pB0, pB1, (bf16_t*)((char*)K_lds + SHM_K), qr, r32, hi);
  fsm<FAST>(pA0, pA1, alA, l_reg, pa0, pa1, pa2, pa3); SBAR();
  pv_d0(o, vb0, pa0, pa1, pa2, pa3); psm<FAST>(pB0, pB1, m_reg, mnB, alB);
  __syncthreads(); if constexpr (!FAST) RESC(alB);
  fsm<FAST>(pB0, pB1, alB, l_reg, pa0, pa1, pa2, pa3); SBAR();
  pv_d0(o, vb0 + (int)SHM_V, pa0, pa1, pa2, pa3);
  { int tid2 = threadIdx.x; asm volatile("" : "+v"(tid2)); const int lane2 = tid2 & 63, r32e = lane2 & 31, hie = lane2 >> 5;
    if (hie == 0) li_l[r32e] = l_reg; asm volatile("s_waitcnt lgkmcnt(0)" ::: "memory");
    float rli[16];
#pragma unroll
    for (int r = 0; r < 16; ++r) rli[r] = __builtin_amdgcn_rcpf(li_l[crow(r, hie)]);
    bf16_t* Ow = Ob + (long)(wid * QBLK) * LDO;
#pragma unroll
    for (int r = 0; r < 16; ++r) { int orow = crow(r, hie);
      for (int d0 = 0; d0 < 4; ++d0) Ow[(long)orow * LDO + d0 * 32 + r32e] = (bf16_t)(cvtpk(o[d0][r] * rli[r], 0.f) & 0xffffu); } }
  __syncthreads();
#undef SLOAD
#undef SWRITE
#undef SWAIT
#undef RESC
}

constexpr int MIXA_RUN = 8;
constexpr int MIXA_LDS_K = 0, MIXA_LDS_V = 65536, MIXA_LDS_BT = 131072, MIXA_LDS_LI = MIXA_LDS_BT + 1024, MIXA_LDS_NEG = MIXA_LDS_LI + NW * 128, MIXA_LDS_BYTES = MIXA_LDS_NEG + 768;
__device__ __forceinline__ void mixa_run(int b, int h, int br, int res, int n0, const bf16_t* __restrict__ proj, const float* __restrict__ btab,
                                         bf16_t* __restrict__ OA, float* __restrict__ LSE, char* lds) {
  int tid_ = threadIdx.x; asm volatile("" : "+v"(tid_));
  const int tid = tid_, wid = __builtin_amdgcn_readfirstlane(tid >> 6), lane = tid & 63, r32 = lane & 31, hi = lane >> 5;
  const int sh = 2 * br, nbt = 128 >> sh, q32 = wid & 3, dh = wid >> 2;
  char* K_lds = lds + MIXA_LDS_K; char* V_lds = lds + MIXA_LDS_V; float* bt = (float*)(lds + MIXA_LDS_BT); float* li_l = (float*)(lds + MIXA_LDS_LI) + wid * 32;
  const size_t rowb = (size_t)b * SEQ;
  const int sr = tid >> 4, sc = (tid & 15) * 8;
  const int kst0 = KSWZ(sr, sc * 2), kst1 = KSWZ(32 + sr, sc * 2), vst0 = v_st(sr, sc), vst1 = v_st(32 + sr, sc);
  const bf16_t* pk = proj + rowb * INW + 1024 + h * 128 + sc; const bf16_t* pv = pk + 1024;
#define MIXA_TLOAD(t, K0, K1, V0, V1) do { const int t_ = (t); const bool ok_ = (t_ >= 0) && (t_ < nbt); const int tt_ = ok_ ? t_ : 0; \
    const size_t o0_ = (size_t)(((64 * tt_ + sr) << sh) + res) * INW, o1_ = (size_t)(((64 * tt_ + 32 + sr) << sh) + res) * INW; \
    K0 = ld8(pk + o0_); K1 = ld8(pk + o1_); V0 = ld8(pv + o0_); V1 = ld8(pv + o1_); \
    if (!ok_) { K0 = bf16x8{}; K1 = bf16x8{}; V0 = bf16x8{}; V1 = bf16x8{}; } } while (0)
#define MIXA_TWRITE(slot, K0, K1, V0, V1) do { *(bf16x8*)(K_lds + (slot) + kst0) = K0; *(bf16x8*)(K_lds + (slot) + kst1) = K1; \
    *(bf16x8*)(V_lds + (slot) + vst0) = V0; *(bf16x8*)(V_lds + (slot) + vst1) = V1; } while (0)
  bf16x8 ak0, ak1, av0, av1, bk0, bk1, bv0, bv1;
  MIXA_TLOAD(n0 - 1, ak0, ak1, av0, av1); MIXA_TLOAD(n0, bk0, bk1, bv0, bv1);
  if (tid < 192) { const int idx = tid - 32; bt[tid] = (idx >= 0 && idx <= 128) ? btab[(br * 8 + h) * 132 + idx] : -1.0e30f; ((float*)(lds + MIXA_LDS_NEG))[tid] = -1.0e30f; }
  MIXA_TWRITE(0, ak0, ak1, av0, av1); MIXA_TWRITE(16384, bk0, bk1, bv0, bv1);
  MIXA_TLOAD(n0 + 1, ak0, ak1, av0, av1); MIXA_TLOAD(n0 + 2, bk0, bk1, bv0, bv1);
  bf16x8 qr[8];
  { const size_t tokq = rowb + ((size_t)(64 * n0 + 32 * q32 + r32) << sh) + res; const bf16_t* Qp = proj + tokq * INW + h * 128 + hi * 8;
#pragma unroll
    for (int d0 = 0; d0 < 8; ++d0) qr[d0] = ld8(Qp + d0 * 16); }
  MIXA_TWRITE(32768, ak0, ak1, av0, av1); MIXA_TWRITE(49152, bk0, bk1, bv0, bv1);
  __syncthreads();
  const float* btl = bt + (4 * hi - r32 + 32); const float* btn = (const float*)(lds + MIXA_LDS_NEG) + (4 * hi - r32 + 32);
  const int vbl = (int)(uintptr_t)V_lds + v_rd_base(lane) + dh * 1024;
  bf16_t* Ob0 = OA + (size_t)br * ((size_t)2 * SEQ * 1024) + h * 128 + dh * 64;
  float* Lb = LSE + (size_t)br * ((size_t)2 * SEQ * 8) + h;
  for (int s = 0; s < MIXA_RUN / 2; ++s) {
    const int nq = n0 + 2 * s, T0 = nq - 1; const bool more = (s + 1 < MIXA_RUN / 2);
    if (more) { MIXA_TLOAD(T0 + 4, ak0, ak1, av0, av1); MIXA_TLOAD(T0 + 5, bk0, bk1, bv0, bv1); }
    f32x16 p[5];
#pragma unroll
    for (int kb = 0; kb < 5; ++kb) { p[kb] = f32x16{}; const int brow = q32 + kb; const int sl = ((2 * s + (brow >> 1)) & 3) * 16384 + (brow & 1) * 8192;
#pragma unroll
      for (int d0 = 0; d0 < 8; ++d0) { const int cb = (d0 * 16 + hi * 8) * 2;
        const bf16x8 a = *reinterpret_cast<const bf16x8*>(K_lds + sl + KSWZ(r32, cb));
        p[kb] = __builtin_amdgcn_mfma_f32_32x32x16_bf16(a, qr[d0], p[kb], 0, 0, 0); }
      SBAR(); }
    const size_t tokq = rowb + ((size_t)(64 * nq + 32 * q32 + r32) << sh) + res;
    if (more) { const bf16_t* Qp = proj + (tokq + ((size_t)128 << sh)) * INW + h * 128 + hi * 8;
#pragma unroll
      for (int d0 = 0; d0 < 8; ++d0) qr[d0] = ld8(Qp + d0 * 16); }
    constexpr float C = SCALE * 1.4426950408889634f;
    float mx = -3.0e38f;
#pragma unroll
    for (int kb = 0; kb < 5; ++kb) { const int tile = (q32 + kb) >> 1;
      const float* tb = ((tile == 0 && T0 < 0) || (tile == 3 && T0 + 3 >= nbt)) ? btn : btl;
#pragma unroll
      for (int r = 0; r < 16; ++r) { const int cidx = 32 * kb + (r & 3) + 8 * (r >> 2);
        const float v = fmaf(p[kb][r], C, tb[cidx]);
        p[kb][r] = v; mx = fmaxf(mx, v); }
      SBAR(); }
    { auto rr = __builtin_amdgcn_permlane32_swap(__float_as_uint(mx), __float_as_uint(mx), false, false); mx = fmaxf(__uint_as_float(rr[0]), __uint_as_float(rr[1])); }
    float sum = 0.f;
    bf16x8 pa[10];
#pragma unroll
    for (int kb = 0; kb < 5; ++kb) {
#pragma unroll
      for (int r = 0; r < 16; ++r) { const float e = __builtin_amdgcn_exp2f(p[kb][r] - mx); p[kb][r] = e; sum += e; }
      ATT_PK4(p[kb], 0, pa[2 * kb]); ATT_PK4(p[kb], 8, pa[2 * kb + 1]); SBAR(); }
    { auto rr = __builtin_amdgcn_permlane32_swap(__float_as_uint(sum), __float_as_uint(sum), false, false); sum = __uint_as_float(rr[0]) + __uint_as_float(rr[1]); }
    f32x16 o0 = f32x16{}, o1 = f32x16{};
#define MIXA_PV(KB) do { const int brow_ = q32 + (KB); const int vb_ = vbl + ((2 * s + (brow_ >> 1)) & 3) * 16384 + (brow_ & 1) * 8192; \
      const s16x4 la_ = tr_read<0>(vb_), ha_ = tr_read<2048>(vb_), lb_ = tr_read<512>(vb_), hb_ = tr_read<512 + 2048>(vb_); \
      const s16x4 lc_ = tr_read<4096>(vb_), hc_ = tr_read<4096 + 2048>(vb_), ld_ = tr_read<4096 + 512>(vb_), hd_ = tr_read<4096 + 512 + 2048>(vb_); \
      asm volatile("s_waitcnt lgkmcnt(0)" ::: "memory"); SBAR(); \
      o0 = __builtin_amdgcn_mfma_f32_32x32x16_bf16(pa[2 * (KB)], ATT_PK(la_, ha_), o0, 0, 0, 0); o1 = __builtin_amdgcn_mfma_f32_32x32x16_bf16(pa[2 * (KB)], ATT_PK(lb_, hb_), o1, 0, 0, 0); \
      o0 = __builtin_amdgcn_mfma_f32_32x32x16_bf16(pa[2 * (KB) + 1], ATT_PK(lc_, hc_), o0, 0, 0, 0); o1 = __builtin_amdgcn_mfma_f32_32x32x16_bf16(pa[2 * (KB) + 1], ATT_PK(ld_, hd_), o1, 0, 0, 0); } while (0)
    MIXA_PV(0); MIXA_PV(1); MIXA_PV(2); MIXA_PV(3); MIXA_PV(4);
#undef MIXA_PV
    if (hi == 0) li_l[r32] = sum; asm volatile("s_waitcnt lgkmcnt(0)" ::: "memory");
    {
      char* ub = (char*)Ob0 + ((rowb + ((size_t)(64 * nq + 32 * q32) << sh) + res) * 1024) * 2;
      const unsigned loff = (((unsigned)(4 * hi) << sh) * 1024u + (unsigned)r32) * 2u;
#pragma unroll
      for (int r = 0; r < 16; ++r) { const float rl = __builtin_amdgcn_rcpf(li_l[crow(r, hi)]);
        const unsigned w = cvtpk(o0[r] * rl, o1[r] * rl);
        bf16_t* dst = (bf16_t*)(ub + ((size_t)(((r & 3) + 8 * (r >> 2)) << sh) * 2048) + loff);
        dst[0] = (bf16_t)(w & 0xffffu); dst[32] = (bf16_t)(w >> 16); } }
    if (dh == 0 && hi == 0) Lb[tokq * 8] = (mx + __builtin_amdgcn_logf(sum)) * 0.6931471805599453f;
    __syncthreads();
    if (more) { MIXA_TWRITE(((2 * s) & 3) * 16384, ak0, ak1, av0, av1); MIXA_TWRITE(((2 * s + 1) & 3) * 16384, bk0, bk1, bv0, bv1); }
    __syncthreads();
  }
#undef MIXA_TLOAD
#undef MIXA_TWRITE
}
#undef SBAR
}

constexpr int NWAVES = 8;
#ifndef MK_N_LAUNCHES
#define MK_N_LAUNCHES 1
#endif
constexpr int N_LAYERS = 2;
#ifndef I8P_MASK
#define I8P_MASK 2
#endif
#ifndef I8D_MASK
#define I8D_MASK 3
#endif
constexpr int I8D = I8D_MASK;
constexpr int I8P = I8P_MASK;
constexpr int PH_PER_LAYER = 9;
constexpr int N_PHASES = 1 + N_LAYERS * PH_PER_LAYER;
constexpr int N_LAUNCHES = MK_N_LAUNCHES;
static_assert(N_LAUNCHES == 1 || N_LAUNCHES == N_PHASES, "MK_N_LAUNCHES is 1 or 19");

constexpr int BATCH = 2, SEQ = 8192, DM = 4096, M = BATCH * SEQ, INW = 9216, FF = 16384;
constexpr int COL_QA = 0, COL_KA = 1024, COL_VA = 2048, COL_GB = 3072, COL_GC = 4096, COL_HB = 5120, COL_QC = 6144, COL_KC = 8192, COL_VC = 8704;
constexpr float EPS = 1e-6f;

constexpr size_t MiB = 1u << 20;
constexpr size_t WS_CTL = 0, WS_CMAX = 64 * 1024, WS_CMAXI = WS_CMAX + (size_t)2 * 16384 * 4, WS_CMAXD = WS_CMAXI + (size_t)2 * 9216 * 4, WS_CSUM = WS_CMAXD + (size_t)2 * 4096 * 4, CTL_ZERO_BYTES = WS_CSUM + (size_t)2 * 4096 * 4;
constexpr size_t WS_ROPE = 1 * MiB;
constexpr size_t WS_BTAB = 1 * MiB + 64 * 1024;
constexpr size_t WS_RS = 1 * MiB + 128 * 1024;
constexpr size_t WS_RMAX = 1 * MiB + 256 * 1024;
constexpr size_t WS_RF = 1 * MiB + 192 * 1024;
constexpr size_t WS_WIN = 2 * MiB, SZ_WIN = (size_t)DM * INW * 2;
constexpr size_t WS_WOUT = WS_WIN + 2 * SZ_WIN, SZ_WOUT = (size_t)DM * DM * 2;
constexpr size_t WS_WUP = WS_WOUT + 2 * SZ_WOUT, SZ_WUP = (size_t)DM * FF * 2;
constexpr size_t WS_WDN = WS_WUP + 2 * SZ_WUP, SZ_WDN = (size_t)DM * FF * 2;
constexpr size_t WS_HN = WS_WDN + 2 * SZ_WDN;
constexpr size_t WS_MIX = WS_HN + (size_t)M * DM * 2;
constexpr size_t WS_Y = WS_MIX + (size_t)M * DM * 2;
constexpr size_t WS_XQ = WS_Y + (size_t)M * DM * 2;
constexpr size_t WS_R = WS_Y + (size_t)M * DM * 4;
constexpr size_t WS_PROJ = WS_R;
constexpr size_t WS_KR = WS_PROJ + (size_t)M * INW * 2;
constexpr size_t WS_OA = WS_KR + (size_t)M * 512 * 2;
constexpr size_t WS_LSE = WS_OA + (size_t)3 * M * 1024 * 4;
constexpr size_t WS_OC = WS_LSE + (size_t)3 * M * 8 * 4;
constexpr size_t WS_END_R = WS_OC + (size_t)M * 2048 * 4;
constexpr size_t WS_H = WS_R;
constexpr size_t WS_HQ = WS_H + (size_t)M * FF * 2;
constexpr size_t WS_END = (WS_END_R > WS_HQ + (size_t)M * FF) ? WS_END_R : WS_HQ + (size_t)M * FF;
static_assert(WS_WIN % 256 == 0 && WS_OC % 256 == 0 && WS_LSE % 256 == 0, "alignment");
constexpr int CW_TMO = 0, CW_CODE = 1;
constexpr int CW_BAR = 4096;

constexpr int RING_OFF = 0, RING_BYTES = 135168;
constexpr int LDSCTL_OFF = RING_BYTES, MISC_OFF = LDSCTL_OFF + 320;
constexpr int LDS_BYTES = 147456;
static_assert(MISC_OFF + 128 <= LDS_BYTES, "LDS map");
static_assert(att::SHM_ATTN <= RING_BYTES && att::MIXA_LDS_BYTES <= RING_BYTES, "attention LDS");

#define GAS __attribute__((address_space(1)))
#define LAS __attribute__((address_space(3)))
typedef unsigned short bf16;
typedef unsigned v4u __attribute__((ext_vector_type(4)));
typedef unsigned v2u __attribute__((ext_vector_type(2)));
typedef float f32x4 __attribute__((ext_vector_type(4)));
typedef float f32x2 __attribute__((ext_vector_type(2)));
typedef GAS unsigned gu32;
#define RLX_AGENT __ATOMIC_RELAXED, __HIP_MEMORY_SCOPE_AGENT
#define LDS_WAIT() asm volatile("s_waitcnt lgkmcnt(0)" ::: "memory")
#define VM_WAIT() asm volatile("s_waitcnt vmcnt(0)" ::: "memory")
__device__ __forceinline__ unsigned f2bf(float f) { unsigned u = __builtin_bit_cast(unsigned, f); return (u + 0x7fffu + ((u >> 16) & 1u)) >> 16; }
__device__ __forceinline__ unsigned pk2(float lo, float hi) { return f2bf(lo) | (f2bf(hi) << 16); }
__device__ __forceinline__ float bflo(unsigned w) { return __uint_as_float(w << 16); }
__device__ __forceinline__ float bfhi(unsigned w) { return __uint_as_float(w & 0xffff0000u); }

#define XB_TMO      128
#define XB_XCNT(j)  (256  + 64 * (j))
#define XB_XSUB(j)  (1280 + 64 * (j))
#define XB_XGEN(j)  (2304 + 64 * (j))
#define XB_TOP      3328
#define XB_TOPGEN   3392
#define XCD_BAR_WORDS 3456
#define XB_SPIN_CAP (1u << 18)

__device__ __forceinline__ unsigned xb_ld(unsigned* p)              { return __hip_atomic_load(p, __ATOMIC_RELAXED, __HIP_MEMORY_SCOPE_AGENT); }
__device__ __forceinline__ unsigned xb_add(unsigned* p, unsigned v) { return __hip_atomic_fetch_add(p, v, __ATOMIC_RELAXED, __HIP_MEMORY_SCOPE_AGENT); }
__device__ __forceinline__ unsigned xb_xcc_id() { return (unsigned)__builtin_amdgcn_s_getreg((3 << 11) | 20) & 0xFu; }
#define XB_SPIN(cond, bar) do { unsigned _sp = 0; while (cond) { __builtin_amdgcn_s_sleep(1); \
    if ((++_sp & 255u) == 0u) { if (xb_ld(&(bar)[XB_TMO])) break; if (_sp > XB_SPIN_CAP) { atomicAdd(&(bar)[XB_TMO], 1u); break; } } } } while (0)

struct XcdBarrier {
    unsigned* bar; unsigned x;
    volatile LAS unsigned* st;
};

__device__ __forceinline__ XcdBarrier xcd_barrier_post(unsigned* bar, volatile LAS unsigned* st) {
    XcdBarrier b; b.bar = bar; b.x = xb_xcc_id(); b.st = st;
    if (threadIdx.x == 0) (void)xb_add(&bar[XB_XCNT(b.x)], 1u);
    return b;
}
__device__ __forceinline__ void xcd_barrier_complete(unsigned* bar, unsigned x, unsigned& nloc, unsigned& nx) {
    const unsigned G = gridDim.x * gridDim.y * gridDim.z;
    unsigned sum, cnt, mine, sp = 0u;
    for (;;) {
        sum = 0u; cnt = 0u; mine = 0u;
#pragma unroll
        for (unsigned j = 0; j < 16; ++j) { const unsigned c = xb_ld(&bar[XB_XCNT(j)]); sum += c; cnt += (c > 0u) ? 1u : 0u; mine = (j == x) ? c : mine; }
        if (sum == G) break;
        __builtin_amdgcn_s_sleep(1);
        if ((++sp & 255u) == 0u) { if (xb_ld(&bar[XB_TMO])) break; if (sp > XB_SPIN_CAP) { atomicAdd(&bar[XB_TMO], 1u); break; } }
    }
    nloc = mine > 0u ? mine : 1u; nx = cnt > 0u ? cnt : 1u;
}

__device__ __forceinline__ void xcd_barrier(const XcdBarrier& b) {
    asm volatile("s_waitcnt vmcnt(0)" ::: "memory");
    __syncthreads();
    if (threadIdx.x == 0) {
        unsigned* bar = b.bar;
        __builtin_amdgcn_s_waitcnt(0);
        unsigned nloc = b.st[0], nx = b.st[1];
        if (nloc == 0u) { xcd_barrier_complete(bar, b.x, nloc, nx); b.st[0] = nloc; b.st[1] = nx; }
        const unsigned old = xb_add(&bar[XB_XSUB(b.x)], 1u);
        const unsigned gen = old / nloc;
        if (old + 1u == (gen + 1u) * nloc) {
            __builtin_amdgcn_fence(__ATOMIC_RELEASE, "agent");
            asm volatile("s_waitcnt vmcnt(0)" ::: "memory");
            const unsigned og = xb_add(&bar[XB_TOP], 1u);
            const unsigned tg = og / nx;
            if (og + 1u == (tg + 1u) * nx) xb_add(&bar[XB_TOPGEN], 1u);
            else XB_SPIN(xb_ld(&bar[XB_TOPGEN]) == tg, bar);
            __builtin_amdgcn_fence(__ATOMIC_ACQUIRE, "agent");
            xb_add(&bar[XB_XGEN(b.x)], 1u);
            asm volatile("s_waitcnt vmcnt(0)" ::: "memory");
        } else {
            XB_SPIN(xb_ld(&bar[XB_XGEN(b.x)]) == gen, bar);
            __builtin_amdgcn_fence(__ATOMIC_ACQUIRE, "agent");
            asm volatile("s_waitcnt vmcnt(0)" ::: "memory");
        }
    }
    __syncthreads();
}
__device__ __forceinline__ float shx(float v, int o, int lane) { return __int_as_float(__builtin_amdgcn_ds_bpermute((lane ^ o) << 2, __float_as_int(v))); }
__device__ __forceinline__ float wave_sum(float v, int lane) {
#pragma unroll
    for (int o = 1; o < 64; o <<= 1) v += shx(v, o, lane);
    return v;
}
__device__ __forceinline__ float dot4(f32x4 a) { return (a.x * a.x + a.y * a.y) + (a.z * a.z + a.w * a.w); }
__device__ __forceinline__ v2u pk4(f32x4 a) { v2u w; w.x = pk2(a.x, a.y); w.y = pk2(a.z, a.w); return w; }

template <bool GSQ = false>
__device__ __forceinline__ void transpose_item(const float* __restrict__ W, int K, int N, bf16* __restrict__ WT, const float* __restrict__ gk, LAS float* scr, int item, int lane) {
    const int nblk = N / 32, kb = item / nblk, nb = item - kb * nblk, k0 = 64 * kb, n0 = 32 * nb;
    const int rr = lane >> 3, c4 = (lane & 7) * 4;
#pragma unroll
    for (int hb = 0; hb < 2; ++hb) {
        f32x4 v[4];
#pragma unroll
        for (int i = 0; i < 4; ++i) v[i] = *(const GAS f32x4*)(W + (size_t)(k0 + 8 * (4 * hb + i) + rr) * N + n0 + c4);
        if (gk) {
#pragma unroll
            for (int i = 0; i < 4; ++i) { float g_ = gk[k0 + 8 * (4 * hb + i) + rr]; if (GSQ) { g_ *= (1.0f / 127.0f); g_ *= g_; } v[i] = v[i] * g_; } }
#pragma unroll
        for (int i = 0; i < 4; ++i) { LAS float* d = scr + (8 * (4 * hb + i) + rr) * 33 + c4; d[0] = v[i].x; d[1] = v[i].y; d[2] = v[i].z; d[3] = v[i].w; }
        asm volatile("" ::: "memory");
    }
    LDS_WAIT(); asm volatile("" ::: "memory");
    const int c = lane & 7;
#pragma unroll
    for (int j = 0; j < 4; ++j) { const int n = (lane >> 3) + 8 * j; const LAS float* s = scr + (8 * c) * 33 + n;
        v4u o; o.x = pk2(s[0 * 33], s[1 * 33]); o.y = pk2(s[2 * 33], s[3 * 33]); o.z = pk2(s[4 * 33], s[5 * 33]); o.w = pk2(s[6 * 33], s[7 * 33]);
        *(GAS v4u*)(WT + ((((size_t)(n0 >> 8) * (K / 64) + kb) * 256 + (n0 & 255) + n) * 64 + 8 * c)) = o; }
    LDS_WAIT(); asm volatile("" ::: "memory");
}
__device__ __forceinline__ void colmax_item(const float* __restrict__ W, int N, const float* __restrict__ gk, unsigned* __restrict__ cmax, int item, int lane, int krows = 512) {
    const int nblk = N / 32, kb = item / nblk, nb = item - kb * nblk, k0 = krows * kb, n0 = 32 * nb;
    const int rr = lane >> 3, c4 = (lane & 7) * 4;
    f32x4 mx = {0.f, 0.f, 0.f, 0.f};
    for (int i0 = 0; i0 < (krows >> 3); i0 += 16) {
        f32x4 v[16];
#pragma unroll
        for (int i = 0; i < 16; ++i) v[i] = *(const GAS f32x4*)(W + (size_t)(k0 + 8 * (i0 + i) + rr) * N + n0 + c4);
#pragma unroll
        for (int i = 0; i < 16; ++i) { const float g_ = gk ? gk[k0 + 8 * (i0 + i) + rr] : 1.0f; const f32x4 t = v[i] * g_;
            mx.x = fmaxf(mx.x, fabsf(t.x)); mx.y = fmaxf(mx.y, fabsf(t.y)); mx.z = fmaxf(mx.z, fabsf(t.z)); mx.w = fmaxf(mx.w, fabsf(t.w)); }
        asm volatile("" ::: "memory");
    }
#pragma unroll
    for (int o = 8; o < 64; o <<= 1) { mx.x = fmaxf(mx.x, shx(mx.x, o, lane)); mx.y = fmaxf(mx.y, shx(mx.y, o, lane)); mx.z = fmaxf(mx.z, shx(mx.z, o, lane)); mx.w = fmaxf(mx.w, shx(mx.w, o, lane)); }
    if (lane < 8) { unsigned* d = cmax + n0 + c4;
        __hip_atomic_fetch_max(d + 0, __float_as_uint(mx.x), __ATOMIC_RELAXED, __HIP_MEMORY_SCOPE_AGENT); __hip_atomic_fetch_max(d + 1, __float_as_uint(mx.y), __ATOMIC_RELAXED, __HIP_MEMORY_SCOPE_AGENT);
        __hip_atomic_fetch_max(d + 2, __float_as_uint(mx.z), __ATOMIC_RELAXED, __HIP_MEMORY_SCOPE_AGENT); __hip_atomic_fetch_max(d + 3, __float_as_uint(mx.w), __ATOMIC_RELAXED, __HIP_MEMORY_SCOPE_AGENT); }
}
__device__ __forceinline__ int q8(float v) { int q = (int)rintf(v); q = q < -127 ? -127 : q; return q > 127 ? 127 : q; }
__device__ __forceinline__ int q8u(float v) { int q = (int)rintf(v); q = q > 255 ? 255 : q; return (q < 0 ? 0 : q) - 128; }
__device__ __forceinline__ unsigned pk4u(float a, float b, float c, float d) {
    unsigned w = __builtin_amdgcn_cvt_pk_u8_f32(a, 0, 0u); w = __builtin_amdgcn_cvt_pk_u8_f32(b, 1, w); w = __builtin_amdgcn_cvt_pk_u8_f32(c, 2, w); return __builtin_amdgcn_cvt_pk_u8_f32(d, 3, w); }
__device__ __forceinline__ unsigned pk4ru(float a, float b, float c, float d) { return pk4u(rintf(a), rintf(b), rintf(c), rintf(d)) ^ 0x80808080u; }
__device__ __forceinline__ unsigned pk4rs(float a, float b, float c, float d, float inv) { return pk4u(rintf(fmaf(a, inv, 128.f)), rintf(fmaf(b, inv, 128.f)), rintf(fmaf(c, inv, 128.f)), rintf(fmaf(d, inv, 128.f))) ^ 0x80808080u; }
__device__ __forceinline__ unsigned pkq4(int a, int b, int c, int d) { return (unsigned)(a & 255) | ((unsigned)(b & 255) << 8) | ((unsigned)(c & 255) << 16) | ((unsigned)d << 24); }
__device__ __forceinline__ void transpose_item_q(const float* __restrict__ W, int K, int N, signed char* __restrict__ WQ, const float* __restrict__ gk, const unsigned* __restrict__ cmax, LAS float* scr, int item, int lane, int* csum = nullptr) {
    const int nblk = N / 32, kb = item / nblk, nb = item - kb * nblk, k0 = 64 * kb, n0 = 32 * nb;
    const int rr = lane >> 3, c4 = (lane & 7) * 4;
#pragma unroll
    for (int hb = 0; hb < 2; ++hb) {
        f32x4 v[4];
#pragma unroll
        for (int i = 0; i < 4; ++i) v[i] = *(const GAS f32x4*)(W + (size_t)(k0 + 8 * (4 * hb + i) + rr) * N + n0 + c4);
#pragma unroll
        for (int i = 0; i < 4; ++i) { if (gk) v[i] = v[i] * gk[k0 + 8 * (4 * hb + i) + rr]; }
#pragma unroll
        for (int i = 0; i < 4; ++i) { LAS float* d = scr + (8 * (4 * hb + i) + rr) * 33 + c4; d[0] = v[i].x; d[1] = v[i].y; d[2] = v[i].z; d[3] = v[i].w; }
        asm volatile("" ::: "memory");
    }
    LDS_WAIT(); asm volatile("" ::: "memory");
    const int c = lane & 3;
#pragma unroll
    for (int j = 0; j < 2; ++j) { const int n = (lane >> 2) + 16 * j; const LAS float* s = scr + (16 * c) * 33 + n;
        const float inv = 127.0f / fmaxf(__uint_as_float(cmax[n0 + n]), 1e-30f);
        float q[16];
#pragma unroll
        for (int e = 0; e < 16; ++e) q[e] = rintf(fmaf(s[e * 33], inv, 128.f));
        v4u o; o.x = pk4u(q[0], q[1], q[2], q[3]) ^ 0x80808080u; o.y = pk4u(q[4], q[5], q[6], q[7]) ^ 0x80808080u; o.z = pk4u(q[8], q[9], q[10], q[11]) ^ 0x80808080u; o.w = pk4u(q[12], q[13], q[14], q[15]) ^ 0x80808080u;
        if (csum) { float tf = 0.f;
#pragma unroll
            for (int e = 0; e < 16; ++e) tf += q[e];
            int t = (int)tf - 16 * 128;
            t += __builtin_amdgcn_ds_bpermute((lane ^ 1) << 2, t); t += __builtin_amdgcn_ds_bpermute((lane ^ 2) << 2, t);
            if (c == 0) (void)__hip_atomic_fetch_add(csum + n0 + n, t, __ATOMIC_RELAXED, __HIP_MEMORY_SCOPE_AGENT); }
        *(GAS v4u*)(WQ + ((((size_t)(n0 >> 8) * (K / 128) + (k0 >> 7)) * 256 + (n0 & 255) + n) * 128 + (k0 & 127) + 16 * c)) = o; }
    LDS_WAIT(); asm volatile("" ::: "memory");
}
__device__ __forceinline__ void unpack8(v4u w, float (&f)[8]) { f[0] = bflo(w.x); f[1] = bfhi(w.x); f[2] = bflo(w.y); f[3] = bfhi(w.y); f[4] = bflo(w.z); f[5] = bfhi(w.z); f[6] = bflo(w.w); f[7] = bfhi(w.w); }
__device__ __forceinline__ v4u pack8(const float (&o)[8]) { v4u w; w.x = pk2(o[0], o[1]); w.y = pk2(o[2], o[3]); w.z = pk2(o[4], o[5]); w.w = pk2(o[6], o[7]); return w; }
template <bool QUANT>
__device__ __forceinline__ void cast_row(const float* __restrict__ xrow, bf16* __restrict__ xbrow, float* rs_out, int lane, signed char* xqrow = nullptr, float* rf_out = nullptr) {
    f32x4 x[8][2]; float s = 0.f, am = 0.f;
#pragma unroll
    for (int j = 0; j < 8; ++j) { x[j][0] = *(const GAS f32x4*)(xrow + 8 * lane + 512 * j); x[j][1] = *(const GAS f32x4*)(xrow + 8 * lane + 512 * j + 4); }
#pragma unroll
    for (int j = 0; j < 8; ++j) { s += dot4(x[j][0]) + dot4(x[j][1]);
        if (QUANT) {
#pragma unroll
            for (int e = 0; e < 4; ++e) am = fmaxf(am, fmaxf(fabsf(x[j][0][e]), fabsf(x[j][1][e]))); }
        else { v4u w; w.x = pk2(x[j][0].x, x[j][0].y); w.y = pk2(x[j][0].z, x[j][0].w); w.z = pk2(x[j][1].x, x[j][1].y); w.w = pk2(x[j][1].z, x[j][1].w);
            *(GAS v4u*)(xbrow + 8 * lane + 512 * j) = w; } }
    const float tot = wave_sum(s, lane); const float rsn = 1.0f / sqrtf(tot * (1.0f / DM) + EPS);
    if (lane == 0) *rs_out = rsn;
    if (QUANT) {
#pragma unroll
        for (int o = 1; o < 64; o <<= 1) am = fmaxf(am, shx(am, o, lane));
        am = fmaxf(am, 1e-30f); const float inv = 127.0f / am;
#pragma unroll
        for (int j = 0; j < 8; ++j) { v2u q;
            q.x = pkq4(q8(x[j][0].x * inv), q8(x[j][0].y * inv), q8(x[j][0].z * inv), q8(x[j][0].w * inv)); q.y = pkq4(q8(x[j][1].x * inv), q8(x[j][1].y * inv), q8(x[j][1].z * inv), q8(x[j][1].w * inv));
            *(GAS v2u*)(xqrow + 8 * lane + 512 * j) = q; }
        if (lane == 0) *rf_out = rsn * am * (1.0f / 127.0f); }
}
template <bool XF32, bool FINAL, bool QUANT = false>
__device__ __forceinline__ void resid_row(const bf16* __restrict__ yrow, const void* xrow, float* orow, bf16* xbrow, float* rs_out, const float* __restrict__ gpost, float eps_y, int lane,
                                          signed char* xqrow = nullptr, float* rf_out = nullptr) {
    v4u yraw[8]; f32x4 xf[8][2]; v4u xr[8]; float s = 0.f; float am = 0.f;
#pragma unroll
    for (int j = 0; j < 8; ++j) yraw[j] = *(const GAS v4u*)(yrow + 8 * lane + 512 * j);
#pragma unroll
    for (int j = 0; j < 8; ++j) {
        if (XF32) { xf[j][0] = *(const GAS f32x4*)((const float*)xrow + 8 * lane + 512 * j); xf[j][1] = *(const GAS f32x4*)((const float*)xrow + 8 * lane + 512 * j + 4); }
        else xr[j] = *(const GAS v4u*)((const bf16*)xrow + 8 * lane + 512 * j); }
#pragma unroll
    for (int j = 0; j < 8; ++j) { float yf[8]; unpack8(yraw[j], yf);
#pragma unroll
        for (int e = 0; e < 8; ++e) s += yf[e] * yf[e]; }
    const float rstd = 1.0f / sqrtf(wave_sum(s, lane) * (1.0f / DM) + eps_y);
    float s2 = 0.f;
#pragma unroll
    for (int j = 0; j < 8; ++j) { const int c = 8 * lane + 512 * j; float yf[8], x[8]; unpack8(yraw[j], yf);
        if (XF32) { x[0] = xf[j][0].x; x[1] = xf[j][0].y; x[2] = xf[j][0].z; x[3] = xf[j][0].w; x[4] = xf[j][1].x; x[5] = xf[j][1].y; x[6] = xf[j][1].z; x[7] = xf[j][1].w; }
        else unpack8(xr[j], x);
        const f32x4 g0 = *(const GAS f32x4*)(gpost + c), g1 = *(const GAS f32x4*)(gpost + c + 4);
#pragma unroll
        for (int e = 0; e < 4; ++e) { x[e] += yf[e] * rstd * g0[e]; x[4 + e] += yf[4 + e] * rstd * g1[e]; }
        if (FINAL) { *(GAS f32x4*)(orow + c) = (f32x4){x[0], x[1], x[2], x[3]}; *(GAS f32x4*)(orow + c + 4) = (f32x4){x[4], x[5], x[6], x[7]}; }
        else {
#pragma unroll
            for (int e = 0; e < 8; ++e) s2 += x[e] * x[e];
            const v4u pw = pack8(x); *(GAS v4u*)(xbrow + c) = pw;
            if (QUANT) { xr[j] = pw;
#pragma unroll
                for (int e = 0; e < 8; ++e) am = fmaxf(am, fabsf(x[e])); } }
        if (j & 1) asm volatile("" ::: "memory"); }
    if (!FINAL) { const float tot = wave_sum(s2, lane); const float rsn = 1.0f / sqrtf(tot * (1.0f / DM) + EPS); if (lane == 0) *rs_out = rsn;
        if (QUANT) {
#pragma unroll
            for (int o = 1; o < 64; o <<= 1) am = fmaxf(am, shx(am, o, lane));
            am = fmaxf(am * 1.00390625f, 1e-30f);
            const float inv = 127.0f / am;
#pragma unroll
            for (int j = 0; j < 8; ++j) { float x[8]; unpack8(xr[j], x); v2u q;
                q.x = pk4rs(x[0], x[1], x[2], x[3], inv); q.y = pk4rs(x[4], x[5], x[6], x[7], inv);
                *(GAS v2u*)(xqrow + 8 * lane + 512 * j) = q; }
            if (lane == 0) *rf_out = rsn * am * (1.0f / 127.0f); } }
}
__device__ __forceinline__ void krope_row(const bf16* __restrict__ prow, bf16* __restrict__ krow, const float* __restrict__ kg, const f32x2* __restrict__ rtab, int t, int lane) {
    const int head = lane >> 4, chunk = lane & 15;
    const v4u raw = *(const GAS v4u*)(prow + COL_KC + head * 128 + chunk * 8);
    float v[8]; unpack8(raw, v); float ss = 0.f;
#pragma unroll
    for (int e = 0; e < 8; ++e) ss += v[e] * v[e];
    ss += shx(ss, 1, lane); ss += shx(ss, 2, lane); ss += shx(ss, 4, lane); ss += shx(ss, 8, lane);
    const float rstd = 1.0f / sqrtf(ss * (1.0f / 128.0f) + EPS);
    const int pos = (chunk < 8) ? (t >> 6) : (t & 63), i0 = (chunk & 3) * 8; const bool second = (chunk & 4) != 0;
    float o[8];
#pragma unroll
    for (int e = 0; e < 8; ++e) { v[e] *= rstd * kg[chunk * 8 + e]; }
#pragma unroll
    for (int e = 0; e < 8; ++e) { const float pr = shx(v[e], 4, lane); const f32x2 cs = rtab[pos * 32 + i0 + e];
        o[e] = second ? (v[e] * cs.x + pr * cs.y) : (v[e] * cs.x - pr * cs.y); }
    v4u w; w.x = pk2(o[0], o[1]); w.y = pk2(o[2], o[3]); w.z = pk2(o[4], o[5]); w.w = pk2(o[6], o[7]);
    *(GAS v4u*)(krow + head * 128 + chunk * 8) = w;
}
__device__ __forceinline__ void conv_row(const bf16* __restrict__ prow, bf16* __restrict__ mrow, const float* __restrict__ cw, const float* __restrict__ gb_gain, int t, int lane) {
    float ob[2][8]; float s = 0.f;
#pragma unroll
    for (int j = 0; j < 2; ++j) { const int c = 8 * lane + 512 * j;
        const v4u z = {0u, 0u, 0u, 0u};
        const v4u rgb = *(const GAS v4u*)(prow + COL_GB + c), rgc = *(const GAS v4u*)(prow + COL_GC + c), rhb = *(const GAS v4u*)(prow + COL_HB + c);
        v4u rgcm = z, rhbm = z, rgcp = z, rhbp = z;
        if (t > 0) { rgcm = *(const GAS v4u*)(prow - INW + COL_GC + c); rhbm = *(const GAS v4u*)(prow - INW + COL_HB + c); }
        if (t < SEQ - 1) { rgcp = *(const GAS v4u*)(prow + INW + COL_GC + c); rhbp = *(const GAS v4u*)(prow + INW + COL_HB + c); }
        float gb[8], gc[8], hb[8], gcm[8], hbm[8], gcp[8], hbp[8];
        unpack8(rgb, gb); unpack8(rgc, gc); unpack8(rhb, hb); unpack8(rgcm, gcm); unpack8(rhbm, hbm); unpack8(rgcp, gcp); unpack8(rhbp, hbp);
#pragma unroll
        for (int e = 0; e < 8; ++e) { const float w0 = cw[c + e], w1 = cw[1024 + c + e], w2 = cw[2048 + c + e];
            const float y = w0 * (gcm[e] * hbm[e]) + w1 * (gc[e] * hb[e]) + w2 * (gcp[e] * hbp[e]);
            ob[j][e] = gb[e] * y; s += ob[j][e] * ob[j][e]; } }
    const float rstd = 1.0f / sqrtf(wave_sum(s, lane) * (1.0f / 1024.0f) + EPS);
#pragma unroll
    for (int j = 0; j < 2; ++j) { const int c = 8 * lane + 512 * j; float o[8];
#pragma unroll
        for (int e = 0; e < 8; ++e) o[e] = ob[j][e] * rstd * gb_gain[c + e];
        v4u w; w.x = pk2(o[0], o[1]); w.y = pk2(o[2], o[3]); w.z = pk2(o[4], o[5]); w.w = pk2(o[6], o[7]);
        *(GAS v4u*)(mrow + 1024 + c) = w; }
}
__device__ __forceinline__ void mix_row(const bf16* __restrict__ OA, const float* __restrict__ LSE, const bf16* __restrict__ OC, bf16* __restrict__ mrow,
                                        const float* __restrict__ ga, const float* __restrict__ gc, int m, int lane) {
    v4u ra[2][3], rc[4];
#pragma unroll
    for (int j = 0; j < 2; ++j) { const int c = 8 * lane + 512 * j;
#pragma unroll
        for (int b = 0; b < 3; ++b) ra[j][b] = *(const GAS v4u*)(OA + ((size_t)b * M + m) * 1024 + c); }
#pragma unroll
    for (int j = 0; j < 4; ++j) rc[j] = *(const GAS v4u*)(OC + (size_t)m * 2048 + 8 * lane + 512 * j);
    { float oa[2][8]; float s = 0.f;
#pragma unroll
      for (int j = 0; j < 2; ++j) { const int head = (lane >> 4) + 4 * j;
        const float l0 = LSE[(size_t)m * 8 + head], l1 = LSE[((size_t)M + m) * 8 + head], l2 = LSE[((size_t)2 * M + m) * 8 + head];
        const float mx = fmaxf(l0, fmaxf(l1, l2)); const float e0 = __expf(l0 - mx), e1 = __expf(l1 - mx), e2 = __expf(l2 - mx); const float inv = 1.0f / (e0 + e1 + e2);
        float a0[8], a1[8], a2[8]; unpack8(ra[j][0], a0); unpack8(ra[j][1], a1); unpack8(ra[j][2], a2);
#pragma unroll
        for (int e = 0; e < 8; ++e) { oa[j][e] = a0[e] * (e0 * inv) + a1[e] * (e1 * inv) + a2[e] * (e2 * inv); s += oa[j][e] * oa[j][e]; } }
      const float rstd = 1.0f / sqrtf(wave_sum(s, lane) * (1.0f / 1024.0f) + EPS);
#pragma unroll
      for (int j = 0; j < 2; ++j) { const int c = 8 * lane + 512 * j; float o[8];
        const f32x4 g0 = *(const GAS f32x4*)(ga + c), g1 = *(const GAS f32x4*)(ga + c + 4);
#pragma unroll
        for (int e = 0; e < 4; ++e) { o[e] = oa[j][e] * rstd * g0[e]; o[4 + e] = oa[j][4 + e] * rstd * g1[e]; }
        *(GAS v4u*)(mrow + c) = pack8(o); } }
    { float oc[4][8]; float s = 0.f;
#pragma unroll
      for (int j = 0; j < 4; ++j) { unpack8(rc[j], oc[j]);
#pragma unroll
        for (int e = 0; e < 8; ++e) s += oc[j][e] * oc[j][e]; }
      const float rstd = 1.0f / sqrtf(wave_sum(s, lane) * (1.0f / 2048.0f) + EPS);
#pragma unroll
      for (int j = 0; j < 4; ++j) { const int c = 8 * lane + 512 * j; float o[8];
        const f32x4 g0 = *(const GAS f32x4*)(gc + c), g1 = *(const GAS f32x4*)(gc + c + 4);
#pragma unroll
        for (int e = 0; e < 4; ++e) { o[e] = oc[j][e] * rstd * g0[e]; o[4 + e] = oc[j][4 + e] * rstd * g1[e]; }
        *(GAS v4u*)(mrow + 2048 + c) = pack8(o); } }
}
__device__ __forceinline__ int t5_bucket(int rel) {
    const int n = rel < 0 ? -rel : rel; const int base = rel > 0 ? 16 : 0;
    if (n < 8) return base + n;
    const float nf = (float)n;
    int large = 8 + (int)(logf(nf / 8.0f) / 4.852030263919617f * 8.0f);
    large = large < 15 ? large : 15;
    return base + large;
}

struct Args { const float* in[16]; float* out; unsigned char* ws; int ph_lo, ph_hi, li, pad; };
typedef const __attribute__((address_space(4))) Args* ArgsP;
__device__ __forceinline__ ArgsP fresh_args() { ArgsP p = (ArgsP)__builtin_amdgcn_kernarg_segment_ptr(); asm volatile("" : "+s"(p)); return p; }
#define FRESH_LANE() ({ int l_ = threadIdx.x & 63; asm volatile("" : "+v"(l_)); l_; })
#ifndef PH_MASK
#define PH_MASK 0x3ff
#endif
#define PH_ON(i) (((PH_MASK) >> (i)) & 1)
#ifndef GEMM_WGM_N4096
#define GEMM_WGM_N4096 4
#endif
#ifndef REPEAT_MASK
#define REPEAT_MASK 0
#endif
#define PH_REP(i) for (int rep_ = 0; rep_ < 1 + (((REPEAT_MASK) >> (i)) & 1); ++rep_)

__global__ void __launch_bounds__(NWAVES * 64, 2) enc_fwd(Args args) {
    extern __shared__ __attribute__((aligned(16))) unsigned char lds[];
    const int wave = __builtin_amdgcn_readfirstlane(threadIdx.x >> 6);
    const int G = gridDim.x, bx = blockIdx.x, vcu = (G % 8 == 0) ? (bx % 8) * (G / 8) + bx / 8 : bx;
    const int gw = vcu * NWAVES + wave, NGW = G * NWAVES;
    LAS unsigned char* ldsl = (LAS unsigned char*)lds;
    volatile LAS unsigned* MISC = (volatile LAS unsigned*)(ldsl + MISC_OFF);
    for (int u = threadIdx.x; u < (LDS_BYTES - LDSCTL_OFF) / 4; u += NWAVES * 64) ((LAS unsigned*)(ldsl + LDSCTL_OFF))[u] = 0u;
    __syncthreads();
    XcdBarrier bar; bar.bar = (unsigned*)((gu32*)(args.ws + WS_CTL) + CW_BAR); bar.x = 0; bar.st = nullptr;
    if (N_LAUNCHES == 1) bar = xcd_barrier_post((unsigned*)((gu32*)(args.ws + WS_CTL) + CW_BAR), MISC + 8);
#define GRID_BAR() do { if (N_LAUNCHES == 1) { xcd_barrier(bar); } } while (0)
    const int lo = args.ph_lo, hi = args.ph_hi;
#define IN(k) (lo <= (k) && (k) < hi)
#define BOTH(k) (IN(k) && IN((k) + 1))

    if (PH_ON(0) && IN(0)) {
        PH_REP(0) {
        ArgsP ap = fresh_args(); unsigned char* ws = ap->ws;
        LAS float* scr = (LAS float*)(ldsl + RING_OFF + wave * 9216);
        constexpr int I_IN = (DM / 64) * (INW / 32), I_OUT = (DM / 64) * (DM / 32), I_UP = (DM / 64) * (FF / 32), I_DN = (FF / 64) * (DM / 32);
        constexpr int I_CM = (DM / 512) * (FF / 32), I_CMI = (DM / 128) * (INW / 32);
        constexpr int I_CMD = (FF / 512) * (DM / 32);
        constexpr int LA0 = I_CM + ((I8P & 1) ? I_CMI : I_IN) + I_OUT + ((I8D & 1) ? I_CMD : I_DN), LA1 = I_CM + ((I8P & 2) ? I_CMI : I_IN) + I_OUT + ((I8D & 2) ? I_CMD : I_DN);
        constexpr int LB0 = I_UP + ((I8P & 1) ? I_IN : 0) + ((I8D & 1) ? I_DN : 0), LB1 = I_UP + ((I8P & 2) ? I_IN : 0) + ((I8D & 2) ? I_DN : 0);
        const int lnp = FRESH_LANE();
        for (int it = gw; it < LA0 + LA1; it += NGW) {
            const int layer = it >= LA0 ? 1 : 0; int r = it - (layer ? LA0 : 0); const bool qin = ((I8P >> layer) & 1) != 0;
            if (r < I_CM) { colmax_item(ap->in[13] + (size_t)layer * DM * FF, FF, ap->in[12] + layer * DM, (unsigned*)(ws + WS_CMAX) + layer * FF, r, lnp); continue; } r -= I_CM;
            if (qin) { if (r < I_CMI) { colmax_item(ap->in[3] + (size_t)layer * DM * INW, INW, ap->in[2] + layer * DM, (unsigned*)(ws + WS_CMAXI) + layer * INW, r, lnp, 128); continue; } r -= I_CMI; }
            else { if (r < I_IN) { transpose_item(ap->in[3] + (size_t)layer * DM * INW, DM, INW, (bf16*)(ws + WS_WIN + layer * SZ_WIN), ap->in[2] + layer * DM, scr, r, lnp); continue; } r -= I_IN; }
            if (r < I_OUT) { transpose_item(ap->in[10] + (size_t)layer * DM * DM, DM, DM, (bf16*)(ws + WS_WOUT + layer * SZ_WOUT), nullptr, scr, r, lnp); continue; } r -= I_OUT;
            if ((I8D >> layer) & 1) colmax_item(ap->in[14] + (size_t)layer * FF * DM, DM, nullptr, (unsigned*)(ws + WS_CMAXD) + layer * DM, r, lnp);
            else transpose_item(ap->in[14] + (size_t)layer * FF * DM, FF, DM, (bf16*)(ws + WS_WDN + layer * SZ_WDN), nullptr, scr, r, lnp);
        }
        { const int gt = bx * (NWAVES * 64) + (int)threadIdx.x; f32x2* rtab = (f32x2*)(ws + WS_ROPE); float* btab = (float*)(ws + WS_BTAB);
          if (gt < 4096) { const int pos = gt >> 5, i = gt & 31; const float inv = (float)pow(10000.0, -(double)i / 32.0); const float ang = (float)pos * inv;
              f32x2 cs; cs.x = cosf(ang); cs.y = sinf(ang); rtab[gt] = cs; }
          else if (gt < 4096 + 3 * 8 * 132) { const int e = gt - 4096, br = e / (8 * 132), h = (e / 132) % 8, k = e % 132; float v = 0.f;
              if (k < 129) { const int rel = (k - 64) << (2 * br); v = ap->in[1][t5_bucket(rel) * 8 + h] * 1.4426950408889634f; }
              btab[e] = v; } }
        { const int ln = FRESH_LANE(); const float* x_in = ap->in[0]; bf16* XB = (bf16*)(ws + WS_HN); float* RS = (float*)(ws + WS_RS);
          for (int m = gw; m < M; m += NGW) { if (I8P & 1) cast_row<true>(x_in + (size_t)m * DM, nullptr, RS + m, ln, (signed char*)(ws + WS_XQ) + (size_t)m * DM, (float*)(ws + WS_RF) + m); else cast_row<false>(x_in + (size_t)m * DM, XB + (size_t)m * DM, RS + m, ln); } }
        GRID_BAR();
        { const int lnq = FRESH_LANE();
          for (int itr = gw; itr < LB0 + LB1; itr += NGW) { const int it = LB0 + LB1 - 1 - itr;
            const int layer = it >= LB0 ? 1 : 0; int r = it - (layer ? LB0 : 0); const unsigned* cm = (const unsigned*)(ws + WS_CMAX) + layer * FF; const bool qin = ((I8P >> layer) & 1) != 0;
            if (r < I_UP) { transpose_item_q(ap->in[13] + (size_t)layer * DM * FF, DM, FF, (signed char*)(ws + WS_WUP + layer * SZ_WUP), ap->in[12] + layer * DM, cm, scr, r, lnq); continue; } r -= I_UP;
            if (qin) { if (r < I_IN) { transpose_item_q(ap->in[3] + (size_t)layer * DM * INW, DM, INW, (signed char*)(ws + WS_WIN + layer * SZ_WIN), ap->in[2] + layer * DM, (const unsigned*)(ws + WS_CMAXI) + layer * INW, scr, r, lnq); continue; } r -= I_IN; }
            transpose_item_q(ap->in[14] + (size_t)layer * FF * DM, FF, DM, (signed char*)(ws + WS_WDN + layer * SZ_WDN), nullptr, (const unsigned*)(ws + WS_CMAXD) + layer * DM, scr, r, lnq, (int*)(ws + WS_CSUM) + layer * DM); } }
        }
        __syncthreads();
    }

    for (int layer = 0; layer < N_LAYERS; ++layer) {
        const int pb = 1 + layer * PH_PER_LAYER;
        if (PH_ON(1) && IN(pb + 0)) {
            PH_REP(1) {
            ArgsP ap = fresh_args(); unsigned char* ws = ap->ws;
            int bxl = bx; asm volatile("" : "+s"(bxl));
            if ((I8P >> layer) & 1) {
            pg8::Gemm g{(const bf16*)(ws + WS_XQ), (const bf16*)(ws + WS_WIN + layer * SZ_WIN), M, INW, DM / 2}; pg8::StaticOrder S; S.init(M, INW, G, bxl);
            pg8::EpiI8P E{(bf16*)(ws + WS_PROJ), INW, (const float*)(ws + WS_RF), (const unsigned*)(ws + WS_CMAXI) + layer * INW};
            pg8::gemm_phase<pg8::EpiI8P, pg8::StaticOrder, true, true, false, true, true>(ldsl + RING_OFF, g, S, E);
            } else {
            pg8::Gemm g{(const bf16*)(ws + WS_HN), (const bf16*)(ws + WS_WIN + layer * SZ_WIN), M, INW, DM}; pg8::StaticOrder S; S.init(M, INW, G, bxl);
            pg8::EpiBf16<0> E{(bf16*)(ws + WS_PROJ), INW, (const float*)(ws + WS_RS)};
            pg8::gemm_phase<pg8::EpiBf16<0>, pg8::StaticOrder, true, true, false, true>(ldsl + RING_OFF, g, S, E);
            }
            }
            if (BOTH(pb + 0)) GRID_BAR();
        }
        if (PH_ON(2) && IN(pb + 1)) {
            PH_REP(2) {
            ArgsP ap = fresh_args(); unsigned char* ws = ap->ws;
            const bf16* PROJ = (const bf16*)(ws + WS_PROJ);
            { const float* kg = ap->in[6] + layer * 128; const float* cw = ap->in[4] + layer * 3 * 1024; const float* gbg = ap->in[8] + layer * 1024;
              bf16* KR = (bf16*)(ws + WS_KR); bf16* MIX = (bf16*)(ws + WS_MIX); const f32x2* rtab = (const f32x2*)(ws + WS_ROPE);
              const int ln = FRESH_LANE(); for (int m = gw; m < M; m += NGW) { const bf16* prow = PROJ + (size_t)m * INW; const int t = m & (SEQ - 1);
                krope_row(prow, KR + (size_t)m * 512, kg, rtab, t, ln);
                conv_row(prow, MIX + (size_t)m * DM, cw, gbg, t, ln); } }
            __syncthreads();
            { const float* btab = (const float*)(ws + WS_BTAB); bf16* OA = (bf16*)(ws + WS_OA); float* LSE = (float*)(ws + WS_LSE);
              for (int R = bx; R < 6144 / att::MIXA_RUN; R += G) { const int rn0 = (R & 15) * att::MIXA_RUN, tt = R >> 4, br = tt % 3, bh = tt / 3, sh = 2 * br;
                att::mixa_run(bh >> 3, bh & 7, br, rn0 >> (7 - sh), rn0 & ((128 >> sh) - 1), PROJ, btab, OA, LSE, (char*)lds + RING_OFF); } }
            }
            if (BOTH(pb + 1)) GRID_BAR();
        }
        if (PH_ON(3) && IN(pb + 2)) {
            PH_REP(3) {
            ArgsP ap = fresh_args(); unsigned char* ws = ap->ws;
            const float* qg = ap->in[5] + layer * 128; const bf16* PROJ = (const bf16*)(ws + WS_PROJ); const bf16* KR = (const bf16*)(ws + WS_KR); bf16* OC = (bf16*)(ws + WS_OC);
            const att::f32x2a* rtab = (const att::f32x2a*)(ws + WS_ROPE);
            bool fastsm;
            { const float* kg = ap->in[6] + layer * 128; float gq = 0.f, gk = 0.f;
              for (int i_ = 0; i_ < 128; ++i_) { gq = fmaxf(gq, fabsf(qg[i_])); gk = fmaxf(gk, fabsf(kg[i_])); }
              const float bound = 128.0f * att::SCALE * 1.4426950408889634f * 1.02f * gq * gk;
              fastsm = __builtin_amdgcn_readfirstlane((int)(bound <= 64.0f)) != 0; }
            if (wave >= 4) __builtin_amdgcn_s_setprio(1);
            if (fastsm) {
            for (int i = 0; ; ++i) { const int U = (G == 256) ? (vcu >> 5) * 128 + i * 32 + (vcu & 31) : i * G + bx; if (i * G >= 1024 || U >= 1024) break;
                const int xk = U >> 7, g4 = (U >> 5) & 3, qb = U & 31, b = xk >> 2, kvh = xk & 3, h = kvh * 4 + g4;
                att::attn_dense_body<true>(PROJ + ((size_t)b * SEQ + qb * 256) * INW + COL_QC + h * 128, KR + (size_t)b * SEQ * 512 + kvh * 128, PROJ + (size_t)b * SEQ * INW + COL_VC + kvh * 128,
                                     OC + ((size_t)b * SEQ + qb * 256) * 2048 + h * 128, qb * 256, qg, rtab, (char*)lds + RING_OFF); }
            } else {
            for (int i = 0; ; ++i) { const int U = (G == 256) ? (vcu >> 5) * 128 + i * 32 + (vcu & 31) : i * G + bx; if (i * G >= 1024 || U >= 1024) break;
                const int xk = U >> 7, g4 = (U >> 5) & 3, qb = U & 31, b = xk >> 2, kvh = xk & 3, h = kvh * 4 + g4;
                att::attn_dense_body<false>(PROJ + ((size_t)b * SEQ + qb * 256) * INW + COL_QC + h * 128, KR + (size_t)b * SEQ * 512 + kvh * 128, PROJ + (size_t)b * SEQ * INW + COL_VC + kvh * 128,
                                     OC + ((size_t)b * SEQ + qb * 256) * 2048 + h * 128, qb * 256, qg, rtab, (char*)lds + RING_OFF); }
            }
            __builtin_amdgcn_s_setprio(0);
            }
            if (BOTH(pb + 2)) GRID_BAR();
        }
        if (PH_ON(4) && IN(pb + 3)) {
            PH_REP(4) {
            ArgsP ap = fresh_args(); unsigned char* ws = ap->ws;
            const float* ga = ap->in[7] + layer * 1024; const float* gc = ap->in[9] + layer * 2048;
            const bf16* OA = (const bf16*)(ws + WS_OA); const float* LSE = (const float*)(ws + WS_LSE); const bf16* OC = (const bf16*)(ws + WS_OC); bf16* MIX = (bf16*)(ws + WS_MIX);
            { const int ln = FRESH_LANE(); for (int m = gw; m < M; m += NGW) mix_row(OA, LSE, OC, MIX + (size_t)m * DM, ga, gc, m, ln); }
            }
            if (BOTH(pb + 3)) GRID_BAR();
        }
        if (PH_ON(5) && IN(pb + 4)) {
            PH_REP(5) {
            ArgsP ap = fresh_args(); unsigned char* ws = ap->ws;
            pg8::Gemm g{(const bf16*)(ws + WS_MIX), (const bf16*)(ws + WS_WOUT + layer * SZ_WOUT), M, DM, DM}; pg8::StaticOrder S; S.init(M, DM, G, bx, GEMM_WGM_N4096);
            pg8::EpiBf16<0> E{(bf16*)(ws + WS_Y), DM, nullptr};
            pg8::gemm_phase<pg8::EpiBf16<0>, pg8::StaticOrder, true, true, false, true>(ldsl + RING_OFF, g, S, E);
            }
            if (BOTH(pb + 4)) GRID_BAR();
        }
        if (PH_ON(6) && IN(pb + 5)) {
            PH_REP(6) {
            ArgsP ap = fresh_args(); unsigned char* ws = ap->ws;
            const float* gpost = ap->in[11] + layer * DM; const bf16* Y = (const bf16*)(ws + WS_Y); bf16* XB = (bf16*)(ws + WS_HN); float* RS = (float*)(ws + WS_RS); signed char* XQ = (signed char*)(ws + WS_XQ); float* RF = (float*)(ws + WS_RF);
            unsigned* RMAX = (unsigned*)(ws + WS_RMAX);
            { const int ln = FRESH_LANE();
              for (int m = gw; m < M; m += NGW) { resid_row<false, false, true>(Y + (size_t)m * DM, XB + (size_t)m * DM, nullptr, XB + (size_t)m * DM, RS + m, gpost, EPS, ln, XQ + (size_t)m * DM, RF + m); if (ln == 0) RMAX[m] = 0u; } }
            }
            if (BOTH(pb + 5)) GRID_BAR();
        }
        if (PH_ON(7) && IN(pb + 6)) {
            PH_REP(7) {
            ArgsP ap = fresh_args(); unsigned char* ws = ap->ws;
            pg8::Gemm g{(const bf16*)(ws + WS_XQ), (const bf16*)(ws + WS_WUP + layer * SZ_WUP), M, FF, DM / 2}; pg8::StaticOrder S; S.init(M, FF, G, bx);
            pg8::EpiI8H E{(bf16*)(ws + WS_H), FF, (const unsigned*)(ws + WS_CMAX) + layer * FF, ((I8D >> layer) & 1) ? (unsigned*)(ws + WS_RMAX) : nullptr};
            pg8::gemm_phase<pg8::EpiI8H, pg8::StaticOrder, true, true, false, true, true>(ldsl + RING_OFF, g, S, E);
            }
            if (BOTH(pb + 6)) GRID_BAR();
        }
        if (PH_ON(8) && IN(pb + 7)) {
            PH_REP(8) {
            ArgsP ap = fresh_args(); unsigned char* ws = ap->ws;
            int bxl = bx; asm volatile("" : "+s"(bxl));
            if ((I8D >> layer) & 1) {
            { const bf16* H = (const bf16*)(ws + WS_H); signed char* HQ = (signed char*)(ws + WS_HQ); const unsigned* RMAX = (const unsigned*)(ws + WS_RMAX);
              int tq = threadIdx.x; asm volatile("" : "+v"(tq));
              const int r = tq >> 3, b16 = tq & 7;
              for (int item = bx; item < (M / 256) * (FF / 128); item += G) { const int pm = item / (FF / 128), kk = item - pm * (FF / 128);
                  const bf16* src = H + (((size_t)pm * (FF / 64) + kk * 2 + (b16 >> 2)) * 256 + r) * 64 + (b16 & 3) * 16; signed char* dst = HQ + (((size_t)pm * (FF / 128) + kk) * 256 + r) * 128 + b16 * 16;
                  v4u lo[4], hi[4]; float inv[4];
#pragma unroll
                  for (int i = 0; i < 4; ++i) { lo[i] = *(const GAS v4u*)(src + i * 64 * 64); hi[i] = *(const GAS v4u*)(src + i * 64 * 64 + 8);
                      const float tm = __uint_as_float(RMAX[pm * 256 + r + 64 * i]); inv[i] = 255.0f / fmaxf(tm * tm * 1.0078125f, 1e-30f); }
#pragma unroll
                  for (int i = 0; i < 4; ++i) { float a[8], b[8]; unpack8(lo[i], a); unpack8(hi[i], b); v4u o;
                      o.x = pk4ru(a[0] * inv[i], a[1] * inv[i], a[2] * inv[i], a[3] * inv[i]); o.y = pk4ru(a[4] * inv[i], a[5] * inv[i], a[6] * inv[i], a[7] * inv[i]);
                      o.z = pk4ru(b[0] * inv[i], b[1] * inv[i], b[2] * inv[i], b[3] * inv[i]); o.w = pk4ru(b[4] * inv[i], b[5] * inv[i], b[6] * inv[i], b[7] * inv[i]);
                      *(GAS v4u*)(dst + i * 64 * 128) = o; } } }
            GRID_BAR();
            pg8::Gemm g{(const bf16*)(ws + WS_HQ), (const bf16*)(ws + WS_WDN + layer * SZ_WDN), M, DM, FF / 2}; pg8::StaticOrder S; S.init(M, DM, G, bxl, GEMM_WGM_N4096);
            pg8::EpiI8D E{(bf16*)(ws + WS_Y), DM, (const unsigned*)(ws + WS_CMAXD) + layer * DM, (const int*)(ws + WS_CSUM) + layer * DM};
            pg8::gemm_phase<pg8::EpiI8D, pg8::StaticOrder, true, true, true, true, true>(ldsl + RING_OFF, g, S, E);
            } else {
            pg8::Gemm g{(const bf16*)(ws + WS_H), (const bf16*)(ws + WS_WDN + layer * SZ_WDN), M, DM, FF}; pg8::StaticOrder S; S.init(M, DM, G, bxl, GEMM_WGM_N4096);
            pg8::EpiBf16<0> E{(bf16*)(ws + WS_Y), DM, nullptr};
            pg8::gemm_phase<pg8::EpiBf16<0>, pg8::StaticOrder, true, true, true, true>(ldsl + RING_OFF, g, S, E);
            }
            }
            if (BOTH(pb + 7)) GRID_BAR();
        }
        if (PH_ON(9) && IN(pb + 8)) {
            PH_REP(9) {
            ArgsP ap = fresh_args(); unsigned char* ws = ap->ws; float* out = ap->out;
            const float* gpost = ap->in[15] + layer * DM; const bf16* Y = (const bf16*)(ws + WS_Y); bf16* XB = (bf16*)(ws + WS_HN); float* RS = (float*)(ws + WS_RS); float* RF = (float*)(ws + WS_RF); signed char* XQ = (signed char*)(ws + WS_XQ); const unsigned* RMAX = (const unsigned*)(ws + WS_RMAX);
            { const int ln = FRESH_LANE();
              if (layer + 1 < N_LAYERS) { for (int m = gw; m < M; m += NGW) { const float r_ = RF[m], r2_ = r_ * r_; float e4_ = r2_ * r2_; if ((I8D >> layer) & 1) { const float tm_ = __uint_as_float(RMAX[m]), hs_ = fmaxf(tm_ * tm_ * 1.0078125f, 1e-30f) * (1.0f / 255.0f); e4_ *= hs_ * hs_; } if ((I8P >> (layer + 1)) & 1) resid_row<false, false, true>(Y + (size_t)m * DM, XB + (size_t)m * DM, nullptr, XB + (size_t)m * DM, RS + m, gpost, EPS / e4_, ln, XQ + (size_t)m * DM, RF + m);
                  else resid_row<false, false>(Y + (size_t)m * DM, XB + (size_t)m * DM, nullptr, XB + (size_t)m * DM, RS + m, gpost, EPS / e4_, ln); } }
              else { for (int m = gw; m < M; m += NGW) { const float r_ = RF[m], r2_ = r_ * r_; float e4_ = r2_ * r2_; if ((I8D >> layer) & 1) { const float tm_ = __uint_as_float(RMAX[m]), hs_ = fmaxf(tm_ * tm_ * 1.0078125f, 1e-30f) * (1.0f / 255.0f); e4_ *= hs_ * hs_; } resid_row<false, true>(Y + (size_t)m * DM, XB + (size_t)m * DM, out + (size_t)m * DM, nullptr, nullptr, gpost, EPS / e4_, ln); } } }
            }
            if (BOTH(pb + 8)) GRID_BAR();
        }
    }
#undef IN
#undef BOTH
#undef GRID_BAR
}

extern "C" void kernel_launch(void* const* d_in, const int* in_sizes, int n_in, void* d_out, int out_size, void* d_ws, size_t ws_size, hipStream_t stream) {
    static int grid = 0;
    if (grid == 0) {
        if (n_in != 16 || in_sizes[0] != M * DM || out_size != M * DM || ws_size < WS_END) {
            fprintf(stderr, "kernel_launch: shape mismatch n_in %d in0 %d out %d ws %zu (need %zu); nothing launched\n", n_in, n_in > 0 ? in_sizes[0] : -1, out_size, ws_size, (size_t)WS_END); grid = -1; return; }
        int dev = 0, cus = 0, per_cu = 0;
        if (hipGetDevice(&dev) != hipSuccess || hipDeviceGetAttribute(&cus, hipDeviceAttributeMultiprocessorCount, dev) != hipSuccess) { grid = -1; return; }
        if (hipFuncSetAttribute((const void*)enc_fwd, hipFuncAttributeMaxDynamicSharedMemorySize, LDS_BYTES) != hipSuccess) { fprintf(stderr, "kernel_launch: hipFuncSetAttribute failed\n"); grid = -1; return; }
        if (hipOccupancyMaxActiveBlocksPerMultiprocessor(&per_cu, (const void*)enc_fwd, NWAVES * 64, LDS_BYTES) != hipSuccess || per_cu < 1) {
            fprintf(stderr, "kernel_launch: occupancy query reports %d workgroups per CU\n", per_cu); }
        (void)hipGetLastError();
        grid = cus;
    }
    if (grid < 0) return;
    if (hipMemsetAsync((char*)d_ws + WS_CTL, 0, CTL_ZERO_BYTES, stream) != hipSuccess) return;
    Args a{};
    for (int i = 0; i < 16; ++i) a.in[i] = (const float*)d_in[i];
    a.out = (float*)d_out; a.ws = (unsigned char*)d_ws;
    for (int li = 0; li < N_LAUNCHES; ++li) {
        a.ph_lo = (N_LAUNCHES == 1) ? 0 : li; a.ph_hi = (N_LAUNCHES == 1) ? N_PHASES : li + 1; a.li = li; a.pad = 0;
        hipLaunchKernelGGL(enc_fwd, dim3(grid), dim3(NWAVES * 64), LDS_BYTES, stream, a);
        const hipError_t le = hipPeekAtLastError();
        if (le != hipSuccess) { fprintf(stderr, "kernel_launch: launch %d failed: %s\n", li, hipGetErrorName(le)); break; }
    }
}
```

```cpp
#include <hip/hip_runtime.h>
#include <cstdio>
#include <cstdint>
namespace pg8 {
#define PG8_LAS __attribute__((address_space(3)))
typedef unsigned short bf16_t;
typedef short bf16x8 __attribute__((ext_vector_type(8)));
typedef float f32x4 __attribute__((ext_vector_type(4)));
typedef unsigned u32x4 __attribute__((ext_vector_type(4)));
constexpr int BM = 256, BK = 64, HALF = 128, HTB = HALF * BK * 2  , STAGE_BYTES = 8 * HTB, NXCD = 8, WGM = 8;

__host__ __device__ __forceinline__ int lds_byte(int r, int c) { const int st = (r >> 4) * 2 + (c >> 5), rr = r & 15, cc = c & 31, ob = rr * 64 + cc * 2; return st * 1024 + (ob ^ (((ob >> 9) & 1) << 5)); }
__host__ __device__ __forceinline__ void stage_rc(int b, int& R, int& C) { const int st = b / 1024, sb = b % 1024, swz = sb ^ (((sb >> 9) & 1) << 5); R = (st >> 1) * 16 + swz / 64; C = (st & 1) * 32 + (swz % 64) / 2; }
__host__ __device__ __forceinline__ int perm32(int rho) { const int n = rho >> 4, i = rho & 15; return 8 * (i >> 2) + 4 * n + (i & 3); }

struct Unit { int pm, pn; };
struct Gemm { const bf16_t* A; const bf16_t* Bt; int M, N, K; };

struct StaticOrder {
    int nM, nN, nwg, G, c, wgm;
    __host__ __device__ void init(int M, int N, int G_, int c_, int wgm_ = WGM) { nM = M / BM; nN = N / BM; nwg = nM * nN; G = G_; c = c_; wgm = wgm_; }
    __host__ __device__ bool next(int i, Unit& u) const {
        const long L = (long)i * G + c; if (L >= nwg) return false;
        int wgid = (int)L; { const int q = nwg / NXCD, r = nwg % NXCD, xcd = wgid % NXCD, off = wgid / NXCD; wgid = (xcd < r ? xcd * (q + 1) : r * (q + 1) + (xcd - r) * q) + off; }
        const int nig = wgm * nN, gid = wgid / nig, fm = gid * wgm, gsz = (nM - fm) < wgm ? (nM - fm) : wgm;
        u.pm = fm + ((wgid % nig) % gsz); u.pn = (wgid % nig) / gsz; return true;
    }
    __device__ __forceinline__ void a_ready(const Unit&) const {}
    __device__ __forceinline__ void done(const Unit&) const {}
};

__device__ __forceinline__ unsigned cvt_pk_bf16(float lo, float hi) { unsigned r; asm volatile("v_cvt_pk_bf16_f32 %0, %1, %2" : "=v"(r) : "v"(lo), "v"(hi)); return r; }
typedef float f32x2 __attribute__((ext_vector_type(2)));
typedef int i32x4 __attribute__((ext_vector_type(4)));
template <bool I8> struct MT;
template <> struct MT<false> { typedef bf16x8 frag; typedef f32x4 acc;
    static __device__ __forceinline__ acc mma(frag a, frag b, acc c) { return __builtin_amdgcn_mfma_f32_16x16x32_bf16(a, b, c, 0, 0, 0); }
    static __device__ __forceinline__ acc zero() { return (f32x4){0.f, 0.f, 0.f, 0.f}; } };
template <> struct MT<true> { typedef i32x4 frag; typedef i32x4 acc;
    static __device__ __forceinline__ acc mma(frag a, frag b, acc c) { return __builtin_amdgcn_mfma_i32_16x16x64_i8(a, b, c, 0, 0, 0); }
    static __device__ __forceinline__ acc zero() { return (i32x4){0, 0, 0, 0}; } };
template <int ACT, bool TILED = false> struct EpiBf16 {
    static constexpr bool PERM = true, AFTER_DRAIN = false;
    bf16_t* O; int ldc; const float* rs;
    __device__ __forceinline__ void operator()(const f32x4 (&acc)[2][2][4][2], const Unit& u, int wr, int wc, int fr, int fq) const {
        const int row0 = u.pm * BM + wr * 64 + fr, col0 = u.pn * BM + wc * 32 + 8 * fq;
#pragma unroll
        for (int ai = 0; ai < 2; ++ai)
#pragma unroll
            for (int m = 0; m < 4; ++m) { const int row = row0 + ai * HALF + m * 16;
                bf16_t* rowp = TILED ? O + ((((size_t)u.pm * (ldc >> 6) + (u.pn * 4 + (wc >> 1))) * 256 + (wr * 64 + fr + ai * HALF + m * 16)) * 64 + (wc & 1) * 32 + 8 * fq)
                                     : O + (size_t)row * ldc + col0;
                const float sc = rs ? rs[row] : 1.0f;
#pragma unroll
                for (int bj = 0; bj < 2; ++bj) { f32x4 v0 = acc[ai][bj][m][0] * sc, v1 = acc[ai][bj][m][1] * sc;
                    if (ACT == 2) {
#pragma unroll
                        for (int e = 0; e < 4; ++e) { const float a = fmaxf(v0[e], 0.f), b = fmaxf(v1[e], 0.f); v0[e] = a * a; v1[e] = b * b; } }
                    u32x4 w; w.x = cvt_pk_bf16(v0[0], v0[1]); w.y = cvt_pk_bf16(v0[2], v0[3]); w.z = cvt_pk_bf16(v1[0], v1[1]); w.w = cvt_pk_bf16(v1[2], v1[3]);
                    *(u32x4*)(rowp + (TILED ? bj * 2 * 256 * 64 : bj * HALF)) = w; } }
    }
};
struct EpiF32 {
    static constexpr bool PERM = false, AFTER_DRAIN = false;
    float* C; int ldc;
    __device__ __forceinline__ void operator()(const f32x4 (&acc)[2][2][4][2], const Unit& u, int wr, int wc, int fr, int fq) const {
        const int row0 = u.pm * BM + wr * 64 + fr, col0 = u.pn * BM + wc * 32 + 4 * fq;
#pragma unroll
        for (int ai = 0; ai < 2; ++ai)
#pragma unroll
            for (int m = 0; m < 4; ++m) { float* rowp = C + (size_t)(row0 + ai * HALF + m * 16) * ldc + col0;
#pragma unroll
                for (int bj = 0; bj < 2; ++bj)
#pragma unroll
                    for (int n = 0; n < 2; ++n) *(f32x4*)(rowp + bj * HALF + n * 16) = acc[ai][bj][m][n]; }
    }
};
struct EpiI8H {
    static constexpr bool PERM = true, AFTER_DRAIN = false;
    bf16_t* O; int ldc; const unsigned* cmax; unsigned* rmax;
    __device__ __forceinline__ void operator()(const i32x4 (&acc)[2][2][4][2], const Unit& u, int wr, int wc, int fr, int fq) const {
        asm volatile("" : "+v"(fr));
        const int col0 = u.pn * BM + wc * 32 + 8 * fq, lane = fr + 16 * fq;
        float cs[2][8];
#pragma unroll
        for (int bj = 0; bj < 2; ++bj) { const u32x4 cb0 = *(const u32x4*)(cmax + col0 + bj * HALF), cb1 = *(const u32x4*)(cmax + col0 + bj * HALF + 4);
#pragma unroll
            for (int e = 0; e < 4; ++e) { cs[bj][e] = __uint_as_float(cb0[e]) * (1.0f / 127.0f); cs[bj][4 + e] = __uint_as_float(cb1[e]) * (1.0f / 127.0f); } }
#pragma unroll
        for (int ai = 0; ai < 2; ++ai)
#pragma unroll
            for (int m = 0; m < 4; ++m) { const int rl = wr * 64 + fr + ai * HALF + m * 16;
                bf16_t* rowp = O + ((((size_t)u.pm * (ldc >> 6) + (u.pn * 4 + (wc >> 1))) * 256 + rl) * 64 + (wc & 1) * 32 + 8 * fq);
                float tm = 0.f;
#pragma unroll
                for (int bj = 0; bj < 2; ++bj) { float v[8];
#pragma unroll
                    for (int e = 0; e < 4; ++e) { const float a = fmaxf((float)acc[ai][bj][m][0][e] * cs[bj][e], 0.f), b = fmaxf((float)acc[ai][bj][m][1][e] * cs[bj][4 + e], 0.f);
                        tm = fmaxf(tm, fmaxf(a, b)); v[e] = a * a; v[4 + e] = b * b; }
                    u32x4 w; w.x = cvt_pk_bf16(v[0], v[1]); w.y = cvt_pk_bf16(v[2], v[3]); w.z = cvt_pk_bf16(v[4], v[5]); w.w = cvt_pk_bf16(v[6], v[7]);
                    *(u32x4*)(rowp + bj * 2 * 256 * 64) = w; }
                if (rmax) {
                    tm = fmaxf(tm, __int_as_float(__builtin_amdgcn_ds_bpermute((lane ^ 16) << 2, __float_as_int(tm))));
                    tm = fmaxf(tm, __int_as_float(__builtin_amdgcn_ds_bpermute((lane ^ 32) << 2, __float_as_int(tm))));
                    if (fq == 0) (void)__hip_atomic_fetch_max(rmax + u.pm * BM + rl, __float_as_uint(tm), __ATOMIC_RELAXED, __HIP_MEMORY_SCOPE_AGENT); } }
    }
};
struct EpiI8D {
    static constexpr bool PERM = true, AFTER_DRAIN = false;
    bf16_t* O; int ldc; const unsigned* cmax; const int* csum;
    __device__ __forceinline__ void operator()(const i32x4 (&acc)[2][2][4][2], const Unit& u, int wr, int wc, int fr, int fq) const {
        const int row0 = u.pm * BM + wr * 64 + fr, col0 = u.pn * BM + wc * 32 + 8 * fq;
#pragma unroll
        for (int bj = 0; bj < 2; ++bj) {
            const u32x4 cb0 = *(const u32x4*)(cmax + col0 + bj * HALF), cb1 = *(const u32x4*)(cmax + col0 + bj * HALF + 4);
            const i32x4 k0 = *(const i32x4*)(csum + col0 + bj * HALF) * 128, k1 = *(const i32x4*)(csum + col0 + bj * HALF + 4) * 128;
#pragma unroll
            for (int ai = 0; ai < 2; ++ai)
#pragma unroll
                for (int m = 0; m < 4; ++m) { const int row = row0 + ai * HALF + m * 16; float v[8];
#pragma unroll
                    for (int e = 0; e < 4; ++e) { v[e] = (float)(acc[ai][bj][m][0][e] + k0[e]) * (__uint_as_float(cb0[e]) * (1.0f / 127.0f)); v[4 + e] = (float)(acc[ai][bj][m][1][e] + k1[e]) * (__uint_as_float(cb1[e]) * (1.0f / 127.0f)); }
                    u32x4 w; w.x = cvt_pk_bf16(v[0], v[1]); w.y = cvt_pk_bf16(v[2], v[3]); w.z = cvt_pk_bf16(v[4], v[5]); w.w = cvt_pk_bf16(v[6], v[7]);
                    *(u32x4*)(O + (size_t)row * ldc + col0 + bj * HALF) = w; } }
    }
};
struct EpiI8P {
    static constexpr bool PERM = true, AFTER_DRAIN = false;
    bf16_t* O; int ldc; const float* rf; const unsigned* cmax;
    __device__ __forceinline__ void operator()(const i32x4 (&acc)[2][2][4][2], const Unit& u, int wr, int wc, int fr, int fq) const {
        const int row0 = u.pm * BM + wr * 64 + fr, col0 = u.pn * BM + wc * 32 + 8 * fq;
#pragma unroll
        for (int ai = 0; ai < 2; ++ai)
#pragma unroll
            for (int m = 0; m < 4; ++m) { const int row = row0 + ai * HALF + m * 16; const float sc = rf[row] * (1.0f / 127.0f);
#pragma unroll
                for (int bj = 0; bj < 2; ++bj) {
                    const u32x4 cb0 = *(const u32x4*)(cmax + col0 + bj * HALF), cb1 = *(const u32x4*)(cmax + col0 + bj * HALF + 4);
                    float v[8];
#pragma unroll
                    for (int e = 0; e < 4; ++e) { v[e] = (float)acc[ai][bj][m][0][e] * sc * __uint_as_float(cb0[e]); v[4 + e] = (float)acc[ai][bj][m][1][e] * sc * __uint_as_float(cb1[e]); }
                    u32x4 w; w.x = cvt_pk_bf16(v[0], v[1]); w.y = cvt_pk_bf16(v[2], v[3]); w.z = cvt_pk_bf16(v[4], v[5]); w.w = cvt_pk_bf16(v[6], v[7]);
                    *(u32x4*)(O + (size_t)row * ldc + col0 + bj * HALF) = w; } }
    }
};

template <class Epi, class Sched, bool ALIGN_EPI = false, bool SP2 = false, bool TILED_A = false, bool TILED_B = false, bool I8 = false>
__device__ __forceinline__ void gemm_phase(PG8_LAS unsigned char* lds, const Gemm g, const Sched& S, const Epi& E) {
    int tid_ = threadIdx.x; asm volatile("" : "+v"(tid_));
    const int tid = tid_, wid = __builtin_amdgcn_readfirstlane(tid >> 6), lane = tid & 63, wr = wid >> 2, wc = wid & 3, fr = lane & 15, fq = lane >> 4;
    const int K = g.K, nt = K / BK;
    unsigned voffA[2], voffB[2];
#pragma unroll
    for (int i = 0; i < 2; ++i) { int R, C; stage_rc(tid * 16 + i * 8192, R, C); const int Rb = Epi::PERM ? ((R & ~31) + perm32(R & 31)) : R;
        voffA[i] = (unsigned)(R * (TILED_A ? BK : K) + C) * 2u; voffB[i] = (unsigned)(Rb * (TILED_B ? BK : K) + C) * 2u; }
    const size_t kstepA = TILED_A ? (size_t)(BM * BK * 2) : (size_t)(BK * 2), kstepB = TILED_B ? (size_t)(BM * BK * 2) : (size_t)(BK * 2);
    const size_t hstepA = TILED_A ? (size_t)(HALF * BK * 2) : (size_t)HALF * K * 2, hstepB = TILED_B ? (size_t)(HALF * BK * 2) : (size_t)HALF * K * 2;
    const size_t tstep = (size_t)BM * K * 2;
    const unsigned ldsw = (unsigned)wid * 1024u;
    const int aoff = lds_byte(wr * 64 + fr, fq * 8), boff = lds_byte(wc * 32 + fr, fq * 8);
#define PG8_SA(b, h) (((b) * 2 + (h)) * HTB)
#define PG8_SB(b, h) ((4 + (b) * 2 + (h)) * HTB)
#define PG8_STAGE(bufoff, gbase, voff) do { _Pragma("unroll") for (int _i = 0; _i < 2; ++_i) \
        __builtin_amdgcn_global_load_lds((const unsigned*)((const char*)(gbase) + (voff)[_i]), (PG8_LAS unsigned*)(lds + (bufoff) + ldsw + _i * 8192), 16, 0, 0); } while (0)
#define PG8_LDA(dst, b, h) do { _Pragma("unroll") for (int m = 0; m < 4; ++m) _Pragma("unroll") for (int k = 0; k < 2; ++k) dst[m][k] = *(const PG8_LAS frag_t*)(lds + PG8_SA(b, h) + aoff + m * 2048 + k * 1024); } while (0)
#define PG8_LDB(dst, b, h) do { _Pragma("unroll") for (int n = 0; n < 2; ++n) _Pragma("unroll") for (int k = 0; k < 2; ++k) dst[n][k] = *(const PG8_LAS frag_t*)(lds + PG8_SB(b, h) + boff + n * 2048 + k * 1024); } while (0)
#define PG8_MMA(ai, bj, At, Bt) do { __builtin_amdgcn_s_setprio(1); _Pragma("unroll") for (int m = 0; m < 4; ++m) _Pragma("unroll") for (int n = 0; n < 2; ++n) _Pragma("unroll") for (int k = 0; k < 2; ++k) \
        acc[ai][bj][m][n] = MT<I8>::mma(Bt[n][k], At[m][k], acc[ai][bj][m][n]); __builtin_amdgcn_s_setprio(0); } while (0)
#define PG8_WAIT_V(n) asm volatile("s_waitcnt vmcnt(" #n ")" ::: "memory")
#define PG8_WAIT_L(n) asm volatile("s_waitcnt lgkmcnt(" #n ")" ::: "memory")
#define PG8_BAR __builtin_amdgcn_s_barrier()
#define PG8_SCHED __builtin_amdgcn_sched_barrier(0)
    Unit cur, nxt; int ui = 0;
    if (!S.next(0, cur)) return;
    typedef typename MT<I8>::frag frag_t; typedef typename MT<I8>::acc acc_t;
    acc_t acc[2][2][4][2];
#pragma unroll
    for (int a = 0; a < 2; ++a)
#pragma unroll
        for (int b = 0; b < 2; ++b)
#pragma unroll
            for (int m = 0; m < 4; ++m)
#pragma unroll
                for (int n = 0; n < 2; ++n) acc[a][b][m][n] = MT<I8>::zero();
    frag_t At[4][2], B0[2][2], B1[2][2];
    const char* cA = (const char*)g.A + (size_t)cur.pm * tstep; const char* cB = (const char*)g.Bt + (size_t)cur.pn * tstep;
    S.a_ready(cur);
    if constexpr (SP2) {
        PG8_STAGE(PG8_SB(0, 0), cB, voffB); PG8_STAGE(PG8_SB(0, 1), cB + hstepB, voffB); PG8_STAGE(PG8_SA(0, 0), cA, voffA); PG8_STAGE(PG8_SA(0, 1), cA + hstepA, voffA);
        if (wr == 1) PG8_BAR;
        PG8_WAIT_V(2); PG8_BAR;
        PG8_STAGE(PG8_SB(1, 0), cB + kstepB, voffB); PG8_STAGE(PG8_SA(1, 0), cA + kstepA, voffA); PG8_STAGE(PG8_SB(1, 1), cB + hstepB + kstepB, voffB);
        PG8_WAIT_V(6); PG8_BAR;
    } else {
        PG8_STAGE(PG8_SB(0, 0), cB, voffB); PG8_STAGE(PG8_SA(0, 0), cA, voffA); PG8_STAGE(PG8_SB(0, 1), cB + hstepB, voffB); PG8_STAGE(PG8_SA(0, 1), cA + hstepA, voffA);
        if (wr == 1) PG8_BAR;
        PG8_WAIT_V(4); PG8_BAR;
        PG8_STAGE(PG8_SB(1, 0), cB + kstepB, voffB); PG8_STAGE(PG8_SA(1, 0), cA + kstepA, voffA); PG8_STAGE(PG8_SB(1, 1), cB + hstepB + kstepB, voffB);
        PG8_WAIT_V(6); PG8_BAR;
    }
    for (;;) {
        const bool has_next = S.next(ui + 1, nxt);
        const char* nA = has_next ? (const char*)g.A + (size_t)nxt.pm * tstep : cA; const char* nB = has_next ? (const char*)g.Bt + (size_t)nxt.pn * tstep : cB;
        for (int t = 0; t < nt; t += 2) {
            const bool last = (t == nt - 2);
            const char* a1 = cA + (size_t)(t + 1) * kstepA;
            const char* a2 = last ? nA : cA + (size_t)(t + 2) * kstepA; const char* b2 = last ? nB : cB + (size_t)(t + 2) * kstepB;
            const char* a3 = a2 + kstepA; const char* b3 = b2 + kstepB;
            if (last && has_next) S.a_ready(nxt);
            if constexpr (SP2) {
            PG8_LDB(B0, 0, 0); PG8_LDB(B1, 0, 1); PG8_SCHED; PG8_LDA(At, 0, 0); PG8_STAGE(PG8_SA(1, 1), a1 + hstepA, voffA);
            PG8_WAIT_V(8); PG8_WAIT_L(0); PG8_BAR; PG8_MMA(0, 0, At, B0); PG8_MMA(0, 1, At, B1); PG8_BAR; PG8_SCHED;
            PG8_LDA(At, 0, 1); PG8_STAGE(PG8_SB(0, 0), b2, voffB); PG8_STAGE(PG8_SB(0, 1), b2 + hstepB, voffB); PG8_STAGE(PG8_SA(0, 0), a2, voffA);
            PG8_WAIT_V(8); PG8_WAIT_L(0); PG8_BAR; PG8_MMA(1, 0, At, B0); PG8_MMA(1, 1, At, B1); PG8_BAR; PG8_SCHED;
            PG8_LDB(B0, 1, 0); PG8_LDB(B1, 1, 1); PG8_SCHED; PG8_LDA(At, 1, 0); PG8_STAGE(PG8_SA(0, 1), a2 + hstepA, voffA);
            PG8_WAIT_V(8); PG8_WAIT_L(0); PG8_BAR; PG8_MMA(0, 0, At, B0); PG8_MMA(0, 1, At, B1); PG8_BAR; PG8_SCHED;
            PG8_LDA(At, 1, 1); PG8_STAGE(PG8_SB(1, 0), b3, voffB); PG8_STAGE(PG8_SB(1, 1), b3 + hstepB, voffB); PG8_STAGE(PG8_SA(1, 0), a3, voffA);
            PG8_WAIT_V(8); PG8_WAIT_L(0); PG8_BAR; PG8_MMA(1, 0, At, B0); PG8_MMA(1, 1, At, B1); PG8_BAR; PG8_SCHED;
            } else {
            PG8_LDB(B0, 0, 0); PG8_SCHED; PG8_LDA(At, 0, 0); PG8_STAGE(PG8_SA(1, 1), a1 + hstepA, voffA);
            PG8_WAIT_L(8); PG8_BAR; PG8_WAIT_L(0); PG8_MMA(0, 0, At, B0); PG8_BAR; PG8_SCHED;
            PG8_LDB(B1, 0, 1); PG8_STAGE(PG8_SB(0, 0), b2, voffB);
            PG8_BAR; PG8_WAIT_L(0); PG8_MMA(0, 1, At, B1); PG8_BAR;
            PG8_LDA(At, 0, 1); PG8_STAGE(PG8_SA(0, 0), a2, voffA);
            PG8_BAR; PG8_WAIT_L(0); PG8_MMA(1, 0, At, B0); PG8_BAR; PG8_SCHED;
            PG8_STAGE(PG8_SB(0, 1), b2 + hstepB, voffB);
            PG8_WAIT_V(6); PG8_BAR; PG8_MMA(1, 1, At, B1); PG8_BAR;
            PG8_LDB(B0, 1, 0); PG8_SCHED; PG8_LDA(At, 1, 0); PG8_STAGE(PG8_SA(0, 1), a2 + hstepA, voffA);
            PG8_WAIT_L(8); PG8_BAR; PG8_WAIT_L(0); PG8_MMA(0, 0, At, B0); PG8_BAR; PG8_SCHED;
            PG8_LDB(B1, 1, 1); PG8_STAGE(PG8_SB(1, 0), b3, voffB);
            PG8_BAR; PG8_WAIT_L(0); PG8_MMA(0, 1, At, B1); PG8_BAR;
            PG8_LDA(At, 1, 1); PG8_STAGE(PG8_SA(1, 0), a3, voffA);
            PG8_BAR; PG8_WAIT_L(0); PG8_MMA(1, 0, At, B0); PG8_BAR; PG8_SCHED;
            PG8_STAGE(PG8_SB(1, 1), b3 + hstepB, voffB);
            PG8_WAIT_V(6); PG8_BAR; PG8_MMA(1, 1, At, B1); PG8_BAR;
            }
        }
        if constexpr (ALIGN_EPI) { if (wr == 0) PG8_BAR; }
        if constexpr (!Epi::AFTER_DRAIN) { E(acc, cur, wr, wc, fr, fq); S.done(cur); }
        if (!has_next) break;
#pragma unroll
        for (int a = 0; a < 2; ++a)
#pragma unroll
            for (int b = 0; b < 2; ++b)
#pragma unroll
                for (int m = 0; m < 4; ++m)
#pragma unroll
                    for (int n = 0; n < 2; ++n) acc[a][b][m][n] = MT<I8>::zero();
        cur = nxt; cA = nA; cB = nB; ++ui;
        if constexpr (ALIGN_EPI) { if (wr == 1) PG8_BAR; }
    }
    PG8_WAIT_V(0);
    if constexpr (!ALIGN_EPI) { if (wr == 0) PG8_BAR; }
    PG8_BAR;
    if constexpr (Epi::AFTER_DRAIN) { E.fused(acc, cur, wr, wc, fr, fq, lds, wid, lane); S.done(cur); }
#undef PG8_SA
#undef PG8_SB
#undef PG8_STAGE
#undef PG8_LDA
#undef PG8_LDB
#undef PG8_MMA
#undef PG8_WAIT_V
#undef PG8_WAIT_L
#undef PG8_BAR
#undef PG8_SCHED
}
}
namespace att {
typedef unsigned short bf16_t;
using bf16x8 = __attribute__((ext_vector_type(8))) short;
using s16x4  = __attribute__((ext_vector_type(4))) short;
using f32x16 = __attribute__((ext_vector_type(16))) float;
using u32x4  = __attribute__((ext_vector_type(4))) unsigned;
typedef float f32x2a __attribute__((ext_vector_type(2)));
typedef float f32x4a __attribute__((ext_vector_type(4)));
constexpr int   D = 128, NW = 8, QBLK = 32, KVBLK = 64;
constexpr float SCALE = 0.088388347648318440f;
constexpr float THR = 8.f;
constexpr int SEQ = 8192, INW = 9216;
constexpr int LDQ = INW, LDKK = 512, LDV = INW, LDO = 2048;
constexpr size_t SHM_V = KVBLK * D * 2, SHM_K = KVBLK * D * 2, SHM_ATTN = 2 * SHM_V + 2 * SHM_K + NW * 64 * 4;
#define KSWZ(row, colB) ((row) * 256 + ((colB) ^ (((row) & 7) << 4)))
#define SBAR() __builtin_amdgcn_sched_barrier(0)
__device__ __forceinline__ int crow(int r, int hi) { return (r & 3) + 8 * (r >> 2) + 4 * hi; }
typedef float f32x2_t __attribute__((ext_vector_type(2))); typedef __bf16 bf16x2_t __attribute__((ext_vector_type(2)));
__device__ __forceinline__ unsigned cvtpk(float lo, float hi) { f32x2_t v = {lo, hi}; bf16x2_t b = __builtin_convertvector(v, bf16x2_t); return __builtin_bit_cast(unsigned, b); }
__device__ __forceinline__ float bf2f(short v) { return __uint_as_float(((unsigned)(unsigned short)v) << 16); }
__device__ __forceinline__ bf16x8 ld8(const bf16_t* p) { return *reinterpret_cast<const bf16x8*>(p); }

__device__ __forceinline__ void partialSM(f32x16& p0, f32x16& p1, float& m_reg, float& mn, float& alpha) {
  constexpr float C = SCALE * 1.4426950408889634f;
  float pmax = p0[0]; for (int r = 1; r < 16; ++r) pmax = fmaxf(pmax, p0[r]); for (int r = 0; r < 16; ++r) pmax = fmaxf(pmax, p1[r]);
  { auto rr = __builtin_amdgcn_permlane32_swap(__float_as_uint(pmax), __float_as_uint(pmax), false, false);
    pmax = fmaxf(__uint_as_float(rr[0]), __uint_as_float(rr[1])); }
  if (__builtin_expect(__all(pmax - m_reg <= THR / SCALE), 1)) { mn = m_reg; alpha = 1.f; }
  else { mn = fmaxf(m_reg, pmax); alpha = __builtin_amdgcn_exp2f((m_reg - mn) * C); m_reg = mn; }
  float mnC = -mn * C;
  for (int r = 0; r < 16; ++r) p0[r] = fmaf(p0[r], C, mnC); for (int r = 0; r < 16; ++r) p1[r] = fmaf(p1[r], C, mnC);
  for (int r = 0; r < 16; ++r) p0[r] = __builtin_amdgcn_exp2f(p0[r]);
}
#define ATT_PK4(P, BASE, OUT) do { unsigned a0 = cvtpk(P[BASE + 0], P[BASE + 1]), a1 = cvtpk(P[BASE + 2], P[BASE + 3]);   \
    unsigned b0 = cvtpk(P[BASE + 4], P[BASE + 5]), b1 = cvtpk(P[BASE + 6], P[BASE + 7]);                              \
    auto r0 = __builtin_amdgcn_permlane32_swap(a0, b0, false, false); auto r1 = __builtin_amdgcn_permlane32_swap(a1, b1, false, false); \
    u32x4 w = {r0[0], r1[0], r0[1], r1[1]}; OUT = *reinterpret_cast<bf16x8*>(&w); } while (0)
__device__ __forceinline__ void finishSM(f32x16& p0, f32x16& p1, float alpha, float& l_reg, bf16x8& pa0, bf16x8& pa1, bf16x8& pa2, bf16x8& pa3) {
  for (int r = 0; r < 16; ++r) p1[r] = __builtin_amdgcn_exp2f(p1[r]);
  float ps = 0; for (int r = 0; r < 16; ++r) ps += p0[r]; for (int r = 0; r < 16; ++r) ps += p1[r];
  { auto rr = __builtin_amdgcn_permlane32_swap(__float_as_uint(ps), __float_as_uint(ps), false, false);
    ps = __uint_as_float(rr[0]) + __uint_as_float(rr[1]); }
  l_reg = l_reg * alpha + ps;
  ATT_PK4(p0, 0, pa0); ATT_PK4(p0, 8, pa1); ATT_PK4(p1, 0, pa2); ATT_PK4(p1, 8, pa3);
}
__device__ __forceinline__ void qkt(f32x16& p0, f32x16& p1, const bf16_t* Ks, const bf16x8* qr, int r32, int hi) {
  p0 = f32x16{}; p1 = f32x16{};
  for (int d0 = 0; d0 < 8; ++d0) { int cb = (d0 * 16 + hi * 8) * 2;
    bf16x8 b0 = *reinterpret_cast<const bf16x8*>((const char*)Ks + KSWZ(r32, cb));
    bf16x8 b1 = *reinterpret_cast<const bf16x8*>((const char*)Ks + KSWZ(32 + r32, cb));
    p0 = __builtin_amdgcn_mfma_f32_32x32x16_bf16(b0, qr[d0], p0, 0, 0, 0);
    p1 = __builtin_amdgcn_mfma_f32_32x32x16_bf16(b1, qr[d0], p1, 0, 0, 0); }
}
__device__ __forceinline__ int v_st(int k, int c) { const int kk = (k & ~0xC) | ((k & 4) << 1) | ((k & 8) >> 1); return ((kk >> 3) * 4 + (c >> 5)) * 512 + ((kk & 7) * 32 + (c & 31)) * 2; }
__device__ __forceinline__ int v_rd_base(int lane) { return ((lane & 3) << 3) | (((lane >> 2) & 3) << 6) | (((lane >> 4) & 1) << 5) | (((lane >> 5) & 1) << 8); }
constexpr int v_rd_off(int d0, int ks, int half) { return d0 * 512 + ks * 4096 + half * 2048; }
template <int OFF> __device__ __forceinline__ s16x4 tr_read(int vb) {
  s16x4 r; asm volatile("ds_read_b64_tr_b16 %0, %1 offset:%2" : "=&v"(r) : "v"(vb), "i"(OFF) : "memory"); return r;
}
#define ATT_PK(L, H) (bf16x8){L[0], L[1], L[2], L[3], H[0], H[1], H[2], H[3]}
template <int D0> __device__ __forceinline__ void pv_one(f32x16& od, int vb, bf16x8 pa0, bf16x8 pa1, bf16x8 pa2, bf16x8 pa3) {
  const s16x4 l0 = tr_read<v_rd_off(D0, 0, 0)>(vb), h0 = tr_read<v_rd_off(D0, 0, 1)>(vb), l1 = tr_read<v_rd_off(D0, 1, 0)>(vb), h1 = tr_read<v_rd_off(D0, 1, 1)>(vb);
  const s16x4 l2 = tr_read<v_rd_off(D0, 2, 0)>(vb), h2 = tr_read<v_rd_off(D0, 2, 1)>(vb), l3 = tr_read<v_rd_off(D0, 3, 0)>(vb), h3 = tr_read<v_rd_off(D0, 3, 1)>(vb);
  asm volatile("s_waitcnt lgkmcnt(0)" ::: "memory"); SBAR();
  od = __builtin_amdgcn_mfma_f32_32x32x16_bf16(pa0, ATT_PK(l0, h0), od, 0, 0, 0);
  od = __builtin_amdgcn_mfma_f32_32x32x16_bf16(pa1, ATT_PK(l1, h1), od, 0, 0, 0);
  od = __builtin_amdgcn_mfma_f32_32x32x16_bf16(pa2, ATT_PK(l2, h2), od, 0, 0, 0);
  od = __builtin_amdgcn_mfma_f32_32x32x16_bf16(pa3, ATT_PK(l3, h3), od, 0, 0, 0);
}
__device__ __forceinline__ void pv_d0(f32x16* o, int vb, bf16x8 pa0, bf16x8 pa1, bf16x8 pa2, bf16x8 pa3) {
  pv_one<0>(o[0], vb, pa0, pa1, pa2, pa3); pv_one<1>(o[1], vb, pa0, pa1, pa2, pa3); pv_one<2>(o[2], vb, pa0, pa1, pa2, pa3); pv_one<3>(o[3], vb, pa0, pa1, pa2, pa3);
}

template <bool FAST> __device__ __forceinline__ void psm(f32x16& p0, f32x16& p1, float& m_reg, float& mn, float& alpha) {
  if constexpr (FAST) { alpha = 1.f; for (int r = 0; r < 16; ++r) p0[r] = __builtin_amdgcn_exp2f(p0[r]); }
  else partialSM(p0, p1, m_reg, mn, alpha);
}
template <bool FAST> __device__ __forceinline__ void fsm(f32x16& p0, f32x16& p1, float alpha, float& l_reg, bf16x8& pa0, bf16x8& pa1, bf16x8& pa2, bf16x8& pa3) {
  if constexpr (FAST) finishSM(p0, p1, 1.f, l_reg, pa0, pa1, pa2, pa3); else finishSM(p0, p1, alpha, l_reg, pa0, pa1, pa2, pa3);
}
template <bool FAST> __device__ __forceinline__ void attn_dense_body(const bf16_t* __restrict__ Qb, const bf16_t* __restrict__ Kh, const bf16_t* __restrict__ Vh,
                                                bf16_t* __restrict__ Ob, int t0, const float* __restrict__ qg, const f32x2a* __restrict__ rtab, char* lds) {
  int tid_ = threadIdx.x; asm volatile("" : "+v"(tid_));
  const int tid = tid_, wid = __builtin_amdgcn_readfirstlane(tid >> 6), lane = tid & 63, r32 = lane & 31, hi = lane >> 5;
  bf16_t* V_lds = (bf16_t*)lds; bf16_t* K_lds = (bf16_t*)(lds + 2 * SHM_V);
  float* ws = (float*)(lds + 2 * SHM_V + 2 * SHM_K) + wid * 64; float* li_l = ws; float* al_l = ws + 32;
  float m_reg = -1e30f, l_reg = 0; f32x16 o[4] = {}; bf16x8 qr[8];
  {
    const int prow = tid >> 4, chunk = tid & 15, i0 = (chunk & 3) * 8; const bool second = (chunk & 4) != 0;
    float gq[8];
#pragma unroll
    for (int e = 0; e < 8; ++e) gq[e] = qg[chunk * 8 + e];
#pragma unroll 2
    for (int p = 0; p < 8; ++p) { const int row = p * 32 + prow;
      const bf16x8 raw = ld8(Qb + (long)row * LDQ + chunk * 8);
      float v[8]; float ss = 0.f;
#pragma unroll
      for (int e = 0; e < 8; ++e) { v[e] = bf2f(raw[e]); ss += v[e] * v[e]; }
      ss += __shfl_xor(ss, 1); ss += __shfl_xor(ss, 2); ss += __shfl_xor(ss, 4); ss += __shfl_xor(ss, 8);
      const float rstd = (FAST ? SCALE * 1.4426950408889634f : 1.0f) / sqrtf(ss * (1.0f / 128.0f) + 1e-6f);
      const int t = t0 + row, pos = (chunk < 8) ? (t >> 6) : (t & 63);
      float o8[8];
#pragma unroll
      for (int e = 0; e < 8; ++e) v[e] *= rstd * gq[e];
#pragma unroll
      for (int e = 0; e < 8; ++e) { const float pr = __shfl_xor(v[e], 4); const f32x2a cs = rtab[pos * 32 + i0 + e];
        o8[e] = second ? (v[e] * cs.x + pr * cs.y) : (v[e] * cs.x - pr * cs.y); }
      u32x4 w = {cvtpk(o8[0], o8[1]), cvtpk(o8[2], o8[3]), cvtpk(o8[4], o8[5]), cvtpk(o8[6], o8[7])};
      *(u32x4*)(lds + KSWZ(row, chunk * 16)) = w; }
    __syncthreads();
#pragma unroll
    for (int d0 = 0; d0 < 8; ++d0) qr[d0] = *reinterpret_cast<const bf16x8*>(lds + KSWZ(wid * QBLK + r32, (d0 * 16 + hi * 8) * 2));
    __syncthreads();
  }
  const int sr = tid >> 4, sc = (tid & 15) * 8, vst0 = v_st(sr, sc), vst1 = v_st(32 + sr, sc);
  const int vb0 = (int)(uintptr_t)V_lds + v_rd_base(lane);
  struct { bf16x8 vs0, vs1, ks0, ks1; } sr_[2];
  const unsigned voff = (unsigned)(sr * LDV + sc) * 2u, koff = (unsigned)(sr * LDKK + sc) * 2u;
#define SLOAD(i, k0) do { const char* vb_ = (const char*)Vh + (size_t)(k0) * (LDV * 2); const char* kb_ = (const char*)Kh + (size_t)(k0) * (LDKK * 2); \
    sr_[i].vs0 = *(const bf16x8*)(vb_ + voff); sr_[i].vs1 = *(const bf16x8*)(vb_ + 32 * LDV * 2 + voff); \
    sr_[i].ks0 = *(const bf16x8*)(kb_ + koff); sr_[i].ks1 = *(const bf16x8*)(kb_ + 32 * LDKK * 2 + koff); } while (0)
#define SWRITE(b, i) do { *(bf16x8*)((char*)V_lds + (b) * SHM_V + vst0) = sr_[i].vs0;          \
    *(bf16x8*)((char*)V_lds + (b) * SHM_V + vst1) = sr_[i].vs1; int kc = sc * 2;               \
    *(bf16x8*)((char*)K_lds + (b) * SHM_K + KSWZ(sr, kc)) = sr_[i].ks0;                       \
    *(bf16x8*)((char*)K_lds + (b) * SHM_K + KSWZ(32 + sr, kc)) = sr_[i].ks1; } while (0)
#define SWAIT() asm volatile("s_waitcnt vmcnt(4)" ::: "memory")
#define RESC(a) do { if (__any((a) < 1.f)) { if (hi == 0) al_l[r32] = (a); asm volatile("s_waitcnt lgkmcnt(0)" ::: "memory"); \
    for (int d = 0; d < 4; ++d) for (int r = 0; r < 16; ++r) o[d][r] *= al_l[crow(r, hi)]; } } while (0)
  f32x16 pA0, pA1, pB0, pB1; float mnA, mnB, alA, alB; bf16x8 pa0, pa1, pa2, pa3; constexpr int NT = SEQ / KVBLK;
  constexpr int SE = 0, SO = 1;
  SLOAD(SE, 0); asm volatile("s_waitcnt vmcnt(0)" ::: "memory"); SWRITE(0, SE); __syncthreads();
  qkt(pA0, pA1, K_lds, qr, r32, hi); psm<FAST>(pA0, pA1, m_reg, mnA, alA);
  SLOAD(SO, KVBLK); SLOAD(SE, 2 * KVBLK);
  SWAIT(); SWRITE(1, SO); __syncthreads();
  for (int j = 1; j + 1 < NT; j += 2) {
    SBAR(); qkt(pB0, pB1, (bf16_t*)((char*)K_lds + SHM_K), qr, r32, hi);
    fsm<FAST>(pA0, pA1, alA, l_reg, pa0, pa1, pa2, pa3); SBAR();
    SLOAD(SO, (j + 2) * KVBLK); SBAR();
    pv_d0(o, vb0, pa0, pa1, pa2, pa3); psm<FAST>(pB0, pB1, m_reg, mnB, alB);
    __syncthreads(); SWAIT(); SWRITE(0, SE);
    if constexpr (!FAST) RESC(alB); __syncthreads();
    SBAR(); qkt(pA0, pA1, K_lds, qr, r32, hi);
    fsm<FAST>(pB0, pB1, alB, l_reg, pa0, pa1, pa2, pa3); SBAR();
    if (j + 3 < NT) SLOAD(SE, (j + 3) * KVBLK); SBAR();
    pv_d0(o, vb0 + (int)SHM_V, pa0, pa1, pa2, pa3); psm<FAST>(pA0, pA1, m_reg, mnA, alA);
    __syncthreads(); SWAIT(); SWRITE(1, SO);
    if constexpr (!FAST) RESC(alA); __syncthreads();
  }
  SBAR(); qkt(pB0, pB1, (bf16_t*)((char*)K_lds + SHM_K), qr, r32, hi);
  fsm<FAST>(pA0, pA1, alA, l_reg, pa0, pa1, pa2, pa3); SBAR();
  pv_d0(o, vb0, pa0, pa1, pa2, pa3); psm<FAST>(pB0, pB1, m_reg, mnB, alB);
  __syncthreads(); if constexpr (!FAST) RESC(alB);
  fsm<FAST>(pB0, pB1, alB, l_reg, pa0, pa1, pa2, pa3); SBAR();
  pv_d0(o, vb0 + (int)SHM_V, pa0, pa1, pa2, pa3);
  { int tid2 = threadIdx.x; asm volatile("" : "+v"(tid2)); const int lane2 = tid2 & 63, r32e = lane2 & 31, hie = lane2 >> 5;
    if (hie == 0) li_l[r32e] = l_reg; asm volatile("s_waitcnt lgkmcnt(0)" ::: "memory");
    float rli[16];
#pragma unroll
    for (int r = 0; r < 16; ++r) rli[r] = __builtin_amdgcn_rcpf(li_l[crow(r, hie)]);
    bf16_t* Ow = Ob + (long)(wid * QBLK) * LDO;
#pragma unroll
    for (int r = 0; r < 16; ++r) { int orow = crow(r, hie);
      for (int d0 = 0; d0 < 4; ++d0) Ow[(long)orow * LDO + d0 * 32 + r32e] = (bf16_t)(cvtpk(o[d0][r] * rli[r], 0.f) & 0xffffu); } }
  __syncthreads();
#undef SLOAD
#undef SWRITE
#undef SWAIT
#undef RESC
}

constexpr int MIXA_RUN = 8;
constexpr int MIXA_LDS_K = 0, MIXA_LDS_V = 65536, MIXA_LDS_BT = 131072, MIXA_LDS_LI = MIXA_LDS_BT + 1024, MIXA_LDS_NEG = MIXA_LDS_LI + NW * 128, MIXA_LDS_BYTES = MIXA_LDS_NEG + 768;
__device__ __forceinline__ void mixa_run(int b, int h, int br, int res, int n0, const bf16_t* __restrict__ proj, const float* __restrict__ btab,
                                         bf16_t* __restrict__ OA, float* __restrict__ LSE, char* lds) {
  int tid_ = threadIdx.x; asm volatile("" : "+v"(tid_));
  const int tid = tid_, wid = __builtin_amdgcn_readfirstlane(tid >> 6), lane = tid & 63, r32 = lane & 31, hi = lane >> 5;
  const int sh = 2 * br, nbt = 128 >> sh, q32 = wid & 3, dh = wid >> 2;
  char* K_lds = lds + MIXA_LDS_K; char* V_lds = lds + MIXA_LDS_V; float* bt = (float*)(lds + MIXA_LDS_BT); float* li_l = (float*)(lds + MIXA_LDS_LI) + wid * 32;
  const size_t rowb = (size_t)b * SEQ;
  const int sr = tid >> 4, sc = (tid & 15) * 8;
  const int kst0 = KSWZ(sr, sc * 2), kst1 = KSWZ(32 + sr, sc * 2), vst0 = v_st(sr, sc), vst1 = v_st(32 + sr, sc);
  const bf16_t* pk = proj + rowb * INW + 1024 + h * 128 + sc; const bf16_t* pv = pk + 1024;
#define MIXA_TLOAD(t, K0, K1, V0, V1) do { const int t_ = (t); const bool ok_ = (t_ >= 0) && (t_ < nbt); const int tt_ = ok_ ? t_ : 0; \
    const size_t o0_ = (size_t)(((64 * tt_ + sr) << sh) + res) * INW, o1_ = (size_t)(((64 * tt_ + 32 + sr) << sh) + res) * INW; \
    K0 = ld8(pk + o0_); K1 = ld8(pk + o1_); V0 = ld8(pv + o0_); V1 = ld8(pv + o1_); \
    if (!ok_) { K0 = bf16x8{}; K1 = bf16x8{}; V0 = bf16x8{}; V1 = bf16x8{}; } } while (0)
#define MIXA_TWRITE(slot, K0, K1, V0, V1) do { *(bf16x8*)(K_lds + (slot) + kst0) = K0; *(bf16x8*)(K_lds + (slot) + kst1) = K1; \
    *(bf16x8*)(V_lds + (slot) + vst0) = V0; *(bf16x8*)(V_lds + (slot) + vst1) = V1; } while (0)
  bf16x8 ak0, ak1, av0, av1, bk0, bk1, bv0, bv1;
  MIXA_TLOAD(n0 - 1, ak0, ak1, av0, av1); MIXA_TLOAD(n0, bk0, bk1, bv0, bv1);
  if (tid < 192) { const int idx = tid - 32; bt[tid] = (idx >= 0 && idx <= 128) ? btab[(br * 8 + h) * 132 + idx] : -1.0e30f; ((float*)(lds + MIXA_LDS_NEG))[tid] = -1.0e30f; }
  MIXA_TWRITE(0, ak0, ak1, av0, av1); MIXA_TWRITE(16384, bk0, bk1, bv0, bv1);
  MIXA_TLOAD(n0 + 1, ak0, ak1, av0, av1); MIXA_TLOAD(n0 + 2, bk0, bk1, bv0, bv1);
  bf16x8 qr[8];
  { const size_t tokq = rowb + ((size_t)(64 * n0 + 32 * q32 + r32) << sh) + res; const bf16_t* Qp = proj + tokq * INW + h * 128 + hi * 8;
#pragma unroll
    for (int d0 = 0; d0 < 8; ++d0) qr[d0] = ld8(Qp + d0 * 16); }
  MIXA_TWRITE(32768, ak0, ak1, av0, av1); MIXA_TWRITE(49152, bk0, bk1, bv0, bv1);
  __syncthreads();
  const float* btl = bt + (4 * hi - r32 + 32); const float* btn = (const float*)(lds + MIXA_LDS_NEG) + (4 * hi - r32 + 32);
  const int vbl = (int)(uintptr_t)V_lds + v_rd_base(lane) + dh * 1024;
  bf16_t* Ob0 = OA + (size_t)br * ((size_t)2 * SEQ * 1024) + h * 128 + dh * 64;
  float* Lb = LSE + (size_t)br * ((size_t)2 * SEQ * 8) + h;
  for (int s = 0; s < MIXA_RUN / 2; ++s) {
    const int nq = n0 + 2 * s, T0 = nq - 1; const bool more = (s + 1 < MIXA_RUN / 2);
    if (more) { MIXA_TLOAD(T0 + 4, ak0, ak1, av0, av1); MIXA_TLOAD(T0 + 5, bk0, bk1, bv0, bv1); }
    f32x16 p[5];
#pragma unroll
    for (int kb = 0; kb < 5; ++kb) { p[kb] = f32x16{}; const int brow = q32 + kb; const int sl = ((2 * s + (brow >> 1)) & 3) * 16384 + (brow & 1) * 8192;
#pragma unroll
      for (int d0 = 0; d0 < 8; ++d0) { const int cb = (d0 * 16 + hi * 8) * 2;
        const bf16x8 a = *reinterpret_cast<const bf16x8*>(K_lds + sl + KSWZ(r32, cb));
        p[kb] = __builtin_amdgcn_mfma_f32_32x32x16_bf16(a, qr[d0], p[kb], 0, 0, 0); }
      SBAR(); }
    const size_t tokq = rowb + ((size_t)(64 * nq + 32 * q32 + r32) << sh) + res;
    if (more) { const bf16_t* Qp = proj + (tokq + ((size_t)128 << sh)) * INW + h * 128 + hi * 8;
#pragma unroll
      for (int d0 = 0; d0 < 8; ++d0) qr[d0] = ld8(Qp + d0 * 16); }
    constexpr float C = SCALE * 1.4426950408889634f;
    float mx = -3.0e38f;
#pragma unroll
    for (int kb = 0; kb < 5; ++kb) { const int tile = (q32 + kb) >> 1;
      const float* tb = ((tile == 0 && T0 < 0) || (tile == 3 && T0 + 3 >= nbt)) ? btn : btl;
#pragma unroll
      for (int r = 0; r < 16; ++r) { const int cidx = 32 * kb + (r & 3) + 8 * (r >> 2);
        const float v = fmaf(p[kb][r], C, tb[cidx]);
        p[kb][r] = v; mx = fmaxf(mx, v); }
      SBAR(); }
    { auto rr = __builtin_amdgcn_permlane32_swap(__float_as_uint(mx), __float_as_uint(mx), false, false); mx = fmaxf(__uint_as_float(rr[0]), __uint_as_float(rr[1])); }
    float sum = 0.f;
    bf16x8 pa[10];
#pragma unroll
    for (int kb = 0; kb < 5; ++kb) {
#pragma unroll
      for (int r = 0; r < 16; ++r) { const float e = __builtin_amdgcn_exp2f(p[kb][r] - mx); p[kb][r] = e; sum += e; }
      ATT_PK4(p[kb], 0, pa[2 * kb]); ATT_PK4(p[kb], 8, pa[2 * kb + 1]); SBAR(); }
    { auto rr = __builtin_amdgcn_permlane32_swap(__float_as_uint(sum), __float_as_uint(sum), false, false); sum = __uint_as_float(rr[0]) + __uint_as_float(rr[1]); }
    f32x16 o0 = f32x16{}, o1 = f32x16{};
#define MIXA_PV(KB) do { const int brow_ = q32 + (KB); const int vb_ = vbl + ((2 * s + (brow_ >> 1)) & 3) * 16384 + (brow_ & 1) * 8192; \
      const s16x4 la_ = tr_read<0>(vb_), ha_ = tr_read<2048>(vb_), lb_ = tr_read<512>(vb_), hb_ = tr_read<512 + 2048>(vb_); \
      const s16x4 lc_ = tr_read<4096>(vb_), hc_ = tr_read<4096 + 2048>(vb_), ld_ = tr_read<4096 + 512>(vb_), hd_ = tr_read<4096 + 512 + 2048>(vb_); \
      asm volatile("s_waitcnt lgkmcnt(0)" ::: "memory"); SBAR(); \
      o0 = __builtin_amdgcn_mfma_f32_32x32x16_bf16(pa[2 * (KB)], ATT_PK(la_, ha_), o0, 0, 0, 0); o1 = __builtin_amdgcn_mfma_f32_32x32x16_bf16(pa[2 * (KB)], ATT_PK(lb_, hb_), o1, 0, 0, 0); \
      o0 = __builtin_amdgcn_mfma_f32_32x32x16_bf16(pa[2 * (KB) + 1], ATT_PK(lc_, hc_), o0, 0, 0, 0); o1 = __builtin_amdgcn_mfma_f32_32x32x16_bf16(pa[2 * (KB) + 1], ATT_PK(ld_, hd_), o1, 0, 0, 0); } while (0)
    MIXA_PV(0); MIXA_PV(1); MIXA_PV(2); MIXA_PV(3); MIXA_PV(4);
#undef MIXA_PV
    if (hi == 0) li_l[r32] = sum; asm volatile("s_waitcnt lgkmcnt(0)" ::: "memory");
    {
      char* ub = (char*)Ob0 + ((rowb + ((size_t)(64 * nq + 32 * q32) << sh) + res) * 1024) * 2;
      const unsigned loff = (((unsigned)(4 * hi) << sh) * 1024u + (unsigned)r32) * 2u;
#pragma unroll
      for (int r = 0; r < 16; ++r) { const float rl = __builtin_amdgcn_rcpf(li_l[crow(r, hi)]);
        const unsigned w = cvtpk(o0[r] * rl, o1[r] * rl);
        bf16_t* dst = (bf16_t*)(ub + ((size_t)(((r & 3) + 8 * (r >> 2)) << sh) * 2048) + loff);
        dst[0] = (bf16_t)(w & 0xffffu); dst[32] = (bf16_t)(w >> 16); } }
    if (dh == 0 && hi == 0) Lb[tokq * 8] = (mx + __builtin_amdgcn_logf(sum)) * 0.6931471805599453f;
    __syncthreads();
    if (more) { MIXA_TWRITE(((2 * s) & 3) * 16384, ak0, ak1, av0, av1); MIXA_TWRITE(((2 * s + 1) & 3) * 16384, bk0, bk1, bv0, bv1); }
    __syncthreads();
  }
#undef MIXA_TLOAD
#undef MIXA_TWRITE
}
#undef SBAR
}

constexpr int NWAVES = 8;
#ifndef MK_N_LAUNCHES
#define MK_N_LAUNCHES 1
#endif
constexpr int N_LAYERS = 2;
#ifndef I8P_MASK
#define I8P_MASK 2
#endif
#ifndef I8D_MASK
#define I8D_MASK 3
#endif
constexpr int I8D = I8D_MASK;
constexpr int I8P = I8P_MASK;
constexpr int PH_PER_LAYER = 9;
constexpr int N_PHASES = 1 + N_LAYERS * PH_PER_LAYER;
constexpr int N_LAUNCHES = MK_N_LAUNCHES;
static_assert(N_LAUNCHES == 1 || N_LAUNCHES == N_PHASES, "MK_N_LAUNCHES is 1 or 19");

constexpr int BATCH = 2, SEQ = 8192, DM = 4096, M = BATCH * SEQ, INW = 9216, FF = 16384;
constexpr int COL_QA = 0, COL_KA = 1024, COL_VA = 2048, COL_GB = 3072, COL_GC = 4096, COL_HB = 5120, COL_QC = 6144, COL_KC = 8192, COL_VC = 8704;
constexpr float EPS = 1e-6f;

constexpr size_t MiB = 1u << 20;
constexpr size_t WS_CTL = 0, WS_CMAX = 64 * 1024, WS_CMAXI = WS_CMAX + (size_t)2 * 16384 * 4, WS_CMAXD = WS_CMAXI + (size_t)2 * 9216 * 4, WS_CSUM = WS_CMAXD + (size_t)2 * 4096 * 4, CTL_ZERO_BYTES = WS_CSUM + (size_t)2 * 4096 * 4;
constexpr size_t WS_ROPE = 1 * MiB;
constexpr size_t WS_BTAB = 1 * MiB + 64 * 1024;
constexpr size_t WS_RS = 1 * MiB + 128 * 1024;
constexpr size_t WS_RMAX = 1 * MiB + 256 * 1024;
constexpr size_t WS_RF = 1 * MiB + 192 * 1024;
constexpr size_t WS_WIN = 2 * MiB, SZ_WIN = (size_t)DM * INW * 2;
constexpr size_t WS_WOUT = WS_WIN + 2 * SZ_WIN, SZ_WOUT = (size_t)DM * DM * 2;
constexpr size_t WS_WUP = WS_WOUT + 2 * SZ_WOUT, SZ_WUP = (size_t)DM * FF * 2;
constexpr size_t WS_WDN = WS_WUP + 2 * SZ_WUP, SZ_WDN = (size_t)DM * FF * 2;
constexpr size_t WS_HN = WS_WDN + 2 * SZ_WDN;
constexpr size_t WS_MIX = WS_HN + (size_t)M * DM * 2;
constexpr size_t WS_Y = WS_MIX + (size_t)M * DM * 2;
constexpr size_t WS_XQ = WS_Y + (size_t)M * DM * 2;
constexpr size_t WS_R = WS_Y + (size_t)M * DM * 4;
constexpr size_t WS_PROJ = WS_R;
constexpr size_t WS_KR = WS_PROJ + (size_t)M * INW * 2;
constexpr size_t WS_OA = WS_KR + (size_t)M * 512 * 2;
constexpr size_t WS_LSE = WS_OA + (size_t)3 * M * 1024 * 4;
constexpr size_t WS_OC = WS_LSE + (size_t)3 * M * 8 * 4;
constexpr size_t WS_END_R = WS_OC + (size_t)M * 2048 * 4;
constexpr size_t WS_H = WS_R;
constexpr size_t WS_HQ = WS_H + (size_t)M * FF * 2;
constexpr size_t WS_END = (WS_END_R > WS_HQ + (size_t)M * FF) ? WS_END_R : WS_HQ + (size_t)M * FF;
static_assert(WS_WIN % 256 == 0 && WS_OC % 256 == 0 && WS_LSE % 256 == 0, "alignment");
constexpr int CW_TMO = 0, CW_CODE = 1;
constexpr int CW_BAR = 4096;

constexpr int RING_OFF = 0, RING_BYTES = 135168;
constexpr int LDSCTL_OFF = RING_BYTES, MISC_OFF = LDSCTL_OFF + 320;
constexpr int LDS_BYTES = 136192;
static_assert(MISC_OFF + 128 <= LDS_BYTES, "LDS map");
static_assert(att::SHM_ATTN <= RING_BYTES && att::MIXA_LDS_BYTES <= RING_BYTES, "attention LDS");

#define GAS __attribute__((address_space(1)))
#define LAS __attribute__((address_space(3)))
typedef unsigned short bf16;
typedef unsigned v4u __attribute__((ext_vector_type(4)));
typedef unsigned v2u __attribute__((ext_vector_type(2)));
typedef float f32x4 __attribute__((ext_vector_type(4)));
typedef float f32x2 __attribute__((ext_vector_type(2)));
typedef GAS unsigned gu32;
#define RLX_AGENT __ATOMIC_RELAXED, __HIP_MEMORY_SCOPE_AGENT
#define LDS_WAIT() asm volatile("s_waitcnt lgkmcnt(0)" ::: "memory")
#define VM_WAIT() asm volatile("s_waitcnt vmcnt(0)" ::: "memory")
__device__ __forceinline__ unsigned f2bf(float f) { unsigned u = __builtin_bit_cast(unsigned, f); return (u + 0x7fffu + ((u >> 16) & 1u)) >> 16; }
__device__ __forceinline__ unsigned pk2(float lo, float hi) { return f2bf(lo) | (f2bf(hi) << 16); }
__device__ __forceinline__ float bflo(unsigned w) { return __uint_as_float(w << 16); }
__device__ __forceinline__ float bfhi(unsigned w) { return __uint_as_float(w & 0xffff0000u); }

#define XB_TMO      128
#define XB_XCNT(j)  (256  + 64 * (j))
#define XB_XSUB(j)  (1280 + 64 * (j))
#define XB_XGEN(j)  (2304 + 64 * (j))
#define XB_TOP      3328
#define XB_TOPGEN   3392
#define XCD_BAR_WORDS 3456
#define XB_SPIN_CAP (1u << 18)

__device__ __forceinline__ unsigned xb_ld(unsigned* p)              { return __hip_atomic_load(p, __ATOMIC_RELAXED, __HIP_MEMORY_SCOPE_AGENT); }
__device__ __forceinline__ unsigned xb_add(unsigned* p, unsigned v) { return __hip_atomic_fetch_add(p, v, __ATOMIC_RELAXED, __HIP_MEMORY_SCOPE_AGENT); }
__device__ __forceinline__ unsigned xb_xcc_id() { return (unsigned)__builtin_amdgcn_s_getreg((3 << 11) | 20) & 0xFu; }
#define XB_SPIN(cond, bar) do { unsigned _sp = 0; while (cond) { __builtin_amdgcn_s_sleep(1); \
    if ((++_sp & 255u) == 0u) { if (xb_ld(&(bar)[XB_TMO])) break; if (_sp > XB_SPIN_CAP) { atomicAdd(&(bar)[XB_TMO], 1u); break; } } } } while (0)

struct XcdBarrier {
    unsigned* bar; unsigned x;
    volatile LAS unsigned* st;
};

__device__ __forceinline__ XcdBarrier xcd_barrier_post(unsigned* bar, volatile LAS unsigned* st) {
    XcdBarrier b; b.bar = bar; b.x = xb_xcc_id(); b.st = st;
    if (threadIdx.x == 0) (void)xb_add(&bar[XB_XCNT(b.x)], 1u);
    return b;
}
__device__ __forceinline__ void xcd_barrier_complete(unsigned* bar, unsigned x, unsigned& nloc, unsigned& nx) {
    const unsigned G = gridDim.x * gridDim.y * gridDim.z;
    unsigned sum, cnt, mine, sp = 0u;
    for (;;) {
        sum = 0u; cnt = 0u; mine = 0u;
#pragma unroll
        for (unsigned j = 0; j < 16; ++j) { const unsigned c = xb_ld(&bar[XB_XCNT(j)]); sum += c; cnt += (c > 0u) ? 1u : 0u; mine = (j == x) ? c : mine; }
        if (sum == G) break;
        __builtin_amdgcn_s_sleep(1);
        if ((++sp & 255u) == 0u) { if (xb_ld(&bar[XB_TMO])) break; if (sp > XB_SPIN_CAP) { atomicAdd(&bar[XB_TMO], 1u); break; } }
    }
    nloc = mine > 0u ? mine : 1u; nx = cnt > 0u ? cnt : 1u;
}

__device__ __forceinline__ void xcd_barrier(const XcdBarrier& b) {
    asm volatile("s_waitcnt vmcnt(0)" ::: "memory");
    __syncthreads();
    if (threadIdx.x == 0) {
        unsigned* bar = b.bar;
        __builtin_amdgcn_s_waitcnt(0);
        unsigned nloc = b.st[0], nx = b.st[1];
        if (nloc == 0u) { xcd_barrier_complete(bar, b.x, nloc, nx); b.st[0] = nloc; b.st[1] = nx; }
        const unsigned old = xb_add(&bar[XB_XSUB(b.x)], 1u);
        const unsigned gen = old / nloc;
        if (old + 1u == (gen + 1u) * nloc) {
            __builtin_amdgcn_fence(__ATOMIC_RELEASE, "agent");
            asm volatile("s_waitcnt vmcnt(0)" ::: "memory");
            const unsigned og = xb_add(&bar[XB_TOP], 1u);
            const unsigned tg = og / nx;
            if (og + 1u == (tg + 1u) * nx) xb_add(&bar[XB_TOPGEN], 1u);
            else XB_SPIN(xb_ld(&bar[XB_TOPGEN]) == tg, bar);
            __builtin_amdgcn_fence(__ATOMIC_ACQUIRE, "agent");
            xb_add(&bar[XB_XGEN(b.x)], 1u);
            asm volatile("s_waitcnt vmcnt(0)" ::: "memory");
        } else {
            XB_SPIN(xb_ld(&bar[XB_XGEN(b.x)]) == gen, bar);
            __builtin_amdgcn_fence(__ATOMIC_ACQUIRE, "agent");
            asm volatile("s_waitcnt vmcnt(0)" ::: "memory");
        }
    }
    __syncthreads();
}
__device__ __forceinline__ float shx(float v, int o, int lane) { return __int_as_float(__builtin_amdgcn_ds_bpermute((lane ^ o) << 2, __float_as_int(v))); }
__device__ __forceinline__ float wave_sum(float v, int lane) {
#pragma unroll
    for (int o = 1; o < 64; o <<= 1) v += shx(v, o, lane);
    return v;
}
__device__ __forceinline__ float dot4(f32x4 a) { return (a.x * a.x + a.y * a.y) + (a.z * a.z + a.w * a.w); }
__device__ __forceinline__ v2u pk4(f32x4 a) { v2u w; w.x = pk2(a.x, a.y); w.y = pk2(a.z, a.w); return w; }

template <bool GSQ = false>
__device__ __forceinline__ void transpose_item(const float* __restrict__ W, int K, int N, bf16* __restrict__ WT, const float* __restrict__ gk, LAS float* scr, int item, int lane) {
    const int nblk = N / 32, kb = item / nblk, nb = item - kb * nblk, k0 = 64 * kb, n0 = 32 * nb;
    const int rr = lane >> 3, c4 = (lane & 7) * 4;
#pragma unroll
    for (int hb = 0; hb < 2; ++hb) {
        f32x4 v[4];
#pragma unroll
        for (int i = 0; i < 4; ++i) v[i] = *(const GAS f32x4*)(W + (size_t)(k0 + 8 * (4 * hb + i) + rr) * N + n0 + c4);
        if (gk) {
#pragma unroll
            for (int i = 0; i < 4; ++i) { float g_ = gk[k0 + 8 * (4 * hb + i) + rr]; if (GSQ) { g_ *= (1.0f / 127.0f); g_ *= g_; } v[i] = v[i] * g_; } }
#pragma unroll
        for (int i = 0; i < 4; ++i) { LAS float* d = scr + (8 * (4 * hb + i) + rr) * 33 + c4; d[0] = v[i].x; d[1] = v[i].y; d[2] = v[i].z; d[3] = v[i].w; }
        asm volatile("" ::: "memory");
    }
    LDS_WAIT(); asm volatile("" ::: "memory");
    const int c = lane & 7;
#pragma unroll
    for (int j = 0; j < 4; ++j) { const int n = (lane >> 3) + 8 * j; const LAS float* s = scr + (8 * c) * 33 + n;
        v4u o; o.x = pk2(s[0 * 33], s[1 * 33]); o.y = pk2(s[2 * 33], s[3 * 33]); o.z = pk2(s[4 * 33], s[5 * 33]); o.w = pk2(s[6 * 33], s[7 * 33]);
        *(GAS v4u*)(WT + ((((size_t)(n0 >> 8) * (K / 64) + kb) * 256 + (n0 & 255) + n) * 64 + 8 * c)) = o; }
    LDS_WAIT(); asm volatile("" ::: "memory");
}
__device__ __forceinline__ void colmax_item(const float* __restrict__ W, int N, const float* __restrict__ gk, unsigned* __restrict__ cmax, int item, int lane, int krows = 512) {
    const int nblk = N / 32, kb = item / nblk, nb = item - kb * nblk, k0 = krows * kb, n0 = 32 * nb;
    const int rr = lane >> 3, c4 = (lane & 7) * 4;
    f32x4 mx = {0.f, 0.f, 0.f, 0.f};
    for (int i0 = 0; i0 < (krows >> 3); i0 += 16) {
        f32x4 v[16];
#pragma unroll
        for (int i = 0; i < 16; ++i) v[i] = *(const GAS f32x4*)(W + (size_t)(k0 + 8 * (i0 + i) + rr) * N + n0 + c4);
#pragma unroll
        for (int i = 0; i < 16; ++i) { const float g_ = gk ? gk[k0 + 8 * (i0 + i) + rr] : 1.0f; const f32x4 t = v[i] * g_;
            mx.x = fmaxf(mx.x, fabsf(t.x)); mx.y = fmaxf(mx.y, fabsf(t.y)); mx.z = fmaxf(mx.z, fabsf(t.z)); mx.w = fmaxf(mx.w, fabsf(t.w)); }
        asm volatile("" ::: "memory");
    }
#pragma unroll
    for (int o = 8; o < 64; o <<= 1) { mx.x = fmaxf(mx.x, shx(mx.x, o, lane)); mx.y = fmaxf(mx.y, shx(mx.y, o, lane)); mx.z = fmaxf(mx.z, shx(mx.z, o, lane)); mx.w = fmaxf(mx.w, shx(mx.w, o, lane)); }
    if (lane < 8) { unsigned* d = cmax + n0 + c4;
        __hip_atomic_fetch_max(d + 0, __float_as_uint(mx.x), __ATOMIC_RELAXED, __HIP_MEMORY_SCOPE_AGENT); __hip_atomic_fetch_max(d + 1, __float_as_uint(mx.y), __ATOMIC_RELAXED, __HIP_MEMORY_SCOPE_AGENT);
        __hip_atomic_fetch_max(d + 2, __float_as_uint(mx.z), __ATOMIC_RELAXED, __HIP_MEMORY_SCOPE_AGENT); __hip_atomic_fetch_max(d + 3, __float_as_uint(mx.w), __ATOMIC_RELAXED, __HIP_MEMORY_SCOPE_AGENT); }
}
__device__ __forceinline__ int q8(float v) { int q = (int)rintf(v); q = q < -127 ? -127 : q; return q > 127 ? 127 : q; }
__device__ __forceinline__ int q8u(float v) { int q = (int)rintf(v); q = q > 255 ? 255 : q; return (q < 0 ? 0 : q) - 128; }
__device__ __forceinline__ unsigned pkq4(int a, int b, int c, int d) { return (unsigned)(a & 255) | ((unsigned)(b & 255) << 8) | ((unsigned)(c & 255) << 16) | ((unsigned)d << 24); }
__device__ __forceinline__ void transpose_item_q(const float* __restrict__ W, int K, int N, signed char* __restrict__ WQ, const float* __restrict__ gk, const unsigned* __restrict__ cmax, LAS float* scr, int item, int lane, int* csum = nullptr) {
    const int nblk = N / 32, kb = item / nblk, nb = item - kb * nblk, k0 = 64 * kb, n0 = 32 * nb;
    const int rr = lane >> 3, c4 = (lane & 7) * 4;
#pragma unroll
    for (int hb = 0; hb < 2; ++hb) {
        f32x4 v[4];
#pragma unroll
        for (int i = 0; i < 4; ++i) v[i] = *(const GAS f32x4*)(W + (size_t)(k0 + 8 * (4 * hb + i) + rr) * N + n0 + c4);
#pragma unroll
        for (int i = 0; i < 4; ++i) { if (gk) v[i] = v[i] * gk[k0 + 8 * (4 * hb + i) + rr]; }
#pragma unroll
        for (int i = 0; i < 4; ++i) { LAS float* d = scr + (8 * (4 * hb + i) + rr) * 33 + c4; d[0] = v[i].x; d[1] = v[i].y; d[2] = v[i].z; d[3] = v[i].w; }
        asm volatile("" ::: "memory");
    }
    LDS_WAIT(); asm volatile("" ::: "memory");
    const int c = lane & 3;
#pragma unroll
    for (int j = 0; j < 2; ++j) { const int n = (lane >> 2) + 16 * j; const LAS float* s = scr + (16 * c) * 33 + n;
        const float inv = 127.0f / fmaxf(__uint_as_float(cmax[n0 + n]), 1e-30f);
        int q[16];
#pragma unroll
        for (int e = 0; e < 16; ++e) q[e] = q8(s[e * 33] * inv);
        v4u o; o.x = pkq4(q[0], q[1], q[2], q[3]); o.y = pkq4(q[4], q[5], q[6], q[7]); o.z = pkq4(q[8], q[9], q[10], q[11]); o.w = pkq4(q[12], q[13], q[14], q[15]);
        if (csum) { int t = 0;
#pragma unroll
            for (int e = 0; e < 16; ++e) t += q[e];
            t += __builtin_amdgcn_ds_bpermute((lane ^ 1) << 2, t); t += __builtin_amdgcn_ds_bpermute((lane ^ 2) << 2, t);
            if (c == 0) (void)__hip_atomic_fetch_add(csum + n0 + n, t, __ATOMIC_RELAXED, __HIP_MEMORY_SCOPE_AGENT); }
        *(GAS v4u*)(WQ + ((((size_t)(n0 >> 8) * (K / 128) + (k0 >> 7)) * 256 + (n0 & 255) + n) * 128 + (k0 & 127) + 16 * c)) = o; }
    LDS_WAIT(); asm volatile("" ::: "memory");
}
__device__ __forceinline__ void unpack8(v4u w, float (&f)[8]) { f[0] = bflo(w.x); f[1] = bfhi(w.x); f[2] = bflo(w.y); f[3] = bfhi(w.y); f[4] = bflo(w.z); f[5] = bfhi(w.z); f[6] = bflo(w.w); f[7] = bfhi(w.w); }
__device__ __forceinline__ v4u pack8(const float (&o)[8]) { v4u w; w.x = pk2(o[0], o[1]); w.y = pk2(o[2], o[3]); w.z = pk2(o[4], o[5]); w.w = pk2(o[6], o[7]); return w; }
template <bool QUANT>
__device__ __forceinline__ void cast_row(const float* __restrict__ xrow, bf16* __restrict__ xbrow, float* rs_out, int lane, signed char* xqrow = nullptr, float* rf_out = nullptr) {
    f32x4 x[8][2]; float s = 0.f, am = 0.f;
#pragma unroll
    for (int j = 0; j < 8; ++j) { x[j][0] = *(const GAS f32x4*)(xrow + 8 * lane + 512 * j); x[j][1] = *(const GAS f32x4*)(xrow + 8 * lane + 512 * j + 4); }
#pragma unroll
    for (int j = 0; j < 8; ++j) { s += dot4(x[j][0]) + dot4(x[j][1]);
        if (QUANT) {
#pragma unroll
            for (int e = 0; e < 4; ++e) am = fmaxf(am, fmaxf(fabsf(x[j][0][e]), fabsf(x[j][1][e]))); }
        else { v4u w; w.x = pk2(x[j][0].x, x[j][0].y); w.y = pk2(x[j][0].z, x[j][0].w); w.z = pk2(x[j][1].x, x[j][1].y); w.w = pk2(x[j][1].z, x[j][1].w);
            *(GAS v4u*)(xbrow + 8 * lane + 512 * j) = w; } }
    const float tot = wave_sum(s, lane); const float rsn = 1.0f / sqrtf(tot * (1.0f / DM) + EPS);
    if (lane == 0) *rs_out = rsn;
    if (QUANT) {
#pragma unroll
        for (int o = 1; o < 64; o <<= 1) am = fmaxf(am, shx(am, o, lane));
        am = fmaxf(am, 1e-30f); const float inv = 127.0f / am;
#pragma unroll
        for (int j = 0; j < 8; ++j) { v2u q;
            q.x = pkq4(q8(x[j][0].x * inv), q8(x[j][0].y * inv), q8(x[j][0].z * inv), q8(x[j][0].w * inv)); q.y = pkq4(q8(x[j][1].x * inv), q8(x[j][1].y * inv), q8(x[j][1].z * inv), q8(x[j][1].w * inv));
            *(GAS v2u*)(xqrow + 8 * lane + 512 * j) = q; }
        if (lane == 0) *rf_out = rsn * am * (1.0f / 127.0f); }
}
template <bool XF32, bool FINAL, bool QUANT = false>
__device__ __forceinline__ void resid_row(const bf16* __restrict__ yrow, const void* xrow, float* orow, bf16* xbrow, float* rs_out, const float* __restrict__ gpost, float eps_y, int lane,
                                          signed char* xqrow = nullptr, float* rf_out = nullptr) {
    v4u yraw[8]; f32x4 xf[8][2]; v4u xr[8]; float s = 0.f; float am = 0.f;
#pragma unroll
    for (int j = 0; j < 8; ++j) yraw[j] = *(const GAS v4u*)(yrow + 8 * lane + 512 * j);
#pragma unroll
    for (int j = 0; j < 8; ++j) {
        if (XF32) { xf[j][0] = *(const GAS f32x4*)((const float*)xrow + 8 * lane + 512 * j); xf[j][1] = *(const GAS f32x4*)((const float*)xrow + 8 * lane + 512 * j + 4); }
        else xr[j] = *(const GAS v4u*)((const bf16*)xrow + 8 * lane + 512 * j); }
#pragma unroll
    for (int j = 0; j < 8; ++j) { float yf[8]; unpack8(yraw[j], yf);
#pragma unroll
        for (int e = 0; e < 8; ++e) s += yf[e] * yf[e]; }
    const float rstd = 1.0f / sqrtf(wave_sum(s, lane) * (1.0f / DM) + eps_y);
    float s2 = 0.f;
#pragma unroll
    for (int j = 0; j < 8; ++j) { const int c = 8 * lane + 512 * j; float yf[8], x[8]; unpack8(yraw[j], yf);
        if (XF32) { x[0] = xf[j][0].x; x[1] = xf[j][0].y; x[2] = xf[j][0].z; x[3] = xf[j][0].w; x[4] = xf[j][1].x; x[5] = xf[j][1].y; x[6] = xf[j][1].z; x[7] = xf[j][1].w; }
        else unpack8(xr[j], x);
        const f32x4 g0 = *(const GAS f32x4*)(gpost + c), g1 = *(const GAS f32x4*)(gpost + c + 4);
#pragma unroll
        for (int e = 0; e < 4; ++e) { x[e] += yf[e] * rstd * g0[e]; x[4 + e] += yf[4 + e] * rstd * g1[e]; }
        if (FINAL) { *(GAS f32x4*)(orow + c) = (f32x4){x[0], x[1], x[2], x[3]}; *(GAS f32x4*)(orow + c + 4) = (f32x4){x[4], x[5], x[6], x[7]}; }
        else {
#pragma unroll
            for (int e = 0; e < 8; ++e) s2 += x[e] * x[e];
            const v4u pw = pack8(x); *(GAS v4u*)(xbrow + c) = pw;
            if (QUANT) { xr[j] = pw;
#pragma unroll
                for (int e = 0; e < 8; ++e) am = fmaxf(am, fabsf(x[e])); } }
        if (j & 1) asm volatile("" ::: "memory"); }
    if (!FINAL) { const float tot = wave_sum(s2, lane); const float rsn = 1.0f / sqrtf(tot * (1.0f / DM) + EPS); if (lane == 0) *rs_out = rsn;
        if (QUANT) {
#pragma unroll
            for (int o = 1; o < 64; o <<= 1) am = fmaxf(am, shx(am, o, lane));
            am = fmaxf(am * 1.00390625f, 1e-30f);
            const float inv = 127.0f / am;
#pragma unroll
            for (int j = 0; j < 8; ++j) { float x[8]; unpack8(xr[j], x); v2u q;
                q.x = pkq4(q8(x[0] * inv), q8(x[1] * inv), q8(x[2] * inv), q8(x[3] * inv)); q.y = pkq4(q8(x[4] * inv), q8(x[5] * inv), q8(x[6] * inv), q8(x[7] * inv));
                *(GAS v2u*)(xqrow + 8 * lane + 512 * j) = q; }
            if (lane == 0) *rf_out = rsn * am * (1.0f / 127.0f); } }
}
__device__ __forceinline__ void krope_row(const bf16* __restrict__ prow, bf16* __restrict__ krow, const float* __restrict__ kg, const f32x2* __restrict__ rtab, int t, int lane) {
    const int head = lane >> 4, chunk = lane & 15;
    const v4u raw = *(const GAS v4u*)(prow + COL_KC + head * 128 + chunk * 8);
    float v[8]; unpack8(raw, v); float ss = 0.f;
#pragma unroll
    for (int e = 0; e < 8; ++e) ss += v[e] * v[e];
    ss += shx(ss, 1, lane); ss += shx(ss, 2, lane); ss += shx(ss, 4, lane); ss += shx(ss, 8, lane);
    const float rstd = 1.0f / sqrtf(ss * (1.0f / 128.0f) + EPS);
    const int pos = (chunk < 8) ? (t >> 6) : (t & 63), i0 = (chunk & 3) * 8; const bool second = (chunk & 4) != 0;
    float o[8];
#pragma unroll
    for (int e = 0; e < 8; ++e) { v[e] *= rstd * kg[chunk * 8 + e]; }
#pragma unroll
    for (int e = 0; e < 8; ++e) { const float pr = shx(v[e], 4, lane); const f32x2 cs = rtab[pos * 32 + i0 + e];
        o[e] = second ? (v[e] * cs.x + pr * cs.y) : (v[e] * cs.x - pr * cs.y); }
    v4u w; w.x = pk2(o[0], o[1]); w.y = pk2(o[2], o[3]); w.z = pk2(o[4], o[5]); w.w = pk2(o[6], o[7]);
    *(GAS v4u*)(krow + head * 128 + chunk * 8) = w;
}
__device__ __forceinline__ void conv_row(const bf16* __restrict__ prow, bf16* __restrict__ mrow, const float* __restrict__ cw, const float* __restrict__ gb_gain, int t, int lane) {
    float ob[2][8]; float s = 0.f;
#pragma unroll
    for (int j = 0; j < 2; ++j) { const int c = 8 * lane + 512 * j;
        const v4u z = {0u, 0u, 0u, 0u};
        const v4u rgb = *(const GAS v4u*)(prow + COL_GB + c), rgc = *(const GAS v4u*)(prow + COL_GC + c), rhb = *(const GAS v4u*)(prow + COL_HB + c);
        v4u rgcm = z, rhbm = z, rgcp = z, rhbp = z;
        if (t > 0) { rgcm = *(const GAS v4u*)(prow - INW + COL_GC + c); rhbm = *(const GAS v4u*)(prow - INW + COL_HB + c); }
        if (t < SEQ - 1) { rgcp = *(const GAS v4u*)(prow + INW + COL_GC + c); rhbp = *(const GAS v4u*)(prow + INW + COL_HB + c); }
        float gb[8], gc[8], hb[8], gcm[8], hbm[8], gcp[8], hbp[8];
        unpack8(rgb, gb); unpack8(rgc, gc); unpack8(rhb, hb); unpack8(rgcm, gcm); unpack8(rhbm, hbm); unpack8(rgcp, gcp); unpack8(rhbp, hbp);
#pragma unroll
        for (int e = 0; e < 8; ++e) { const float w0 = cw[c + e], w1 = cw[1024 + c + e], w2 = cw[2048 + c + e];
            const float y = w0 * (gcm[e] * hbm[e]) + w1 * (gc[e] * hb[e]) + w2 * (gcp[e] * hbp[e]);
            ob[j][e] = gb[e] * y; s += ob[j][e] * ob[j][e]; } }
    const float rstd = 1.0f / sqrtf(wave_sum(s, lane) * (1.0f / 1024.0f) + EPS);
#pragma unroll
    for (int j = 0; j < 2; ++j) { const int c = 8 * lane + 512 * j; float o[8];
#pragma unroll
        for (int e = 0; e < 8; ++e) o[e] = ob[j][e] * rstd * gb_gain[c + e];
        v4u w; w.x = pk2(o[0], o[1]); w.y = pk2(o[2], o[3]); w.z = pk2(o[4], o[5]); w.w = pk2(o[6], o[7]);
        *(GAS v4u*)(mrow + 1024 + c) = w; }
}
__device__ __forceinline__ void mix_row(const bf16* __restrict__ OA, const float* __restrict__ LSE, const bf16* __restrict__ OC, bf16* __restrict__ mrow,
                                        const float* __restrict__ ga, const float* __restrict__ gc, int m, int lane) {
    v4u ra[2][3], rc[4];
#pragma unroll
    for (int j = 0; j < 2; ++j) { const int c = 8 * lane + 512 * j;
#pragma unroll
        for (int b = 0; b < 3; ++b) ra[j][b] = *(const GAS v4u*)(OA + ((size_t)b * M + m) * 1024 + c); }
#pragma unroll
    for (int j = 0; j < 4; ++j) rc[j] = *(const GAS v4u*)(OC + (size_t)m * 2048 + 8 * lane + 512 * j);
    { float oa[2][8]; float s = 0.f;
#pragma unroll
      for (int j = 0; j < 2; ++j) { const int head = (lane >> 4) + 4 * j;
        const float l0 = LSE[(size_t)m * 8 + head], l1 = LSE[((size_t)M + m) * 8 + head], l2 = LSE[((size_t)2 * M + m) * 8 + head];
        const float mx = fmaxf(l0, fmaxf(l1, l2)); const float e0 = __expf(l0 - mx), e1 = __expf(l1 - mx), e2 = __expf(l2 - mx); const float inv = 1.0f / (e0 + e1 + e2);
        float a0[8], a1[8], a2[8]; unpack8(ra[j][0], a0); unpack8(ra[j][1], a1); unpack8(ra[j][2], a2);
#pragma unroll
        for (int e = 0; e < 8; ++e) { oa[j][e] = a0[e] * (e0 * inv) + a1[e] * (e1 * inv) + a2[e] * (e2 * inv); s += oa[j][e] * oa[j][e]; } }
      const float rstd = 1.0f / sqrtf(wave_sum(s, lane) * (1.0f / 1024.0f) + EPS);
#pragma unroll
      for (int j = 0; j < 2; ++j) { const int c = 8 * lane + 512 * j; float o[8];
        const f32x4 g0 = *(const GAS f32x4*)(ga + c), g1 = *(const GAS f32x4*)(ga + c + 4);
#pragma unroll
        for (int e = 0; e < 4; ++e) { o[e] = oa[j][e] * rstd * g0[e]; o[4 + e] = oa[j][4 + e] * rstd * g1[e]; }
        *(GAS v4u*)(mrow + c) = pack8(o); } }
    { float oc[4][8]; float s = 0.f;
#pragma unroll
      for (int j = 0; j < 4; ++j) { unpack8(rc[j], oc[j]);
#pragma unroll
        for (int e = 0; e < 8; ++e) s += oc[j][e] * oc[j][e]; }
      const float rstd = 1.0f / sqrtf(wave_sum(s, lane) * (1.0f / 2048.0f) + EPS);
#pragma unroll
      for (int j = 0; j < 4; ++j) { const int c = 8 * lane + 512 * j; float o[8];
        const f32x4 g0 = *(const GAS f32x4*)(gc + c), g1 = *(const GAS f32x4*)(gc + c + 4);
#pragma unroll
        for (int e = 0; e < 4; ++e) { o[e] = oc[j][e] * rstd * g0[e]; o[4 + e] = oc[j][4 + e] * rstd * g1[e]; }
        *(GAS v4u*)(mrow + 2048 + c) = pack8(o); } }
}
__device__ __forceinline__ int t5_bucket(int rel) {
    const int n = rel < 0 ? -rel : rel; const int base = rel > 0 ? 16 : 0;
    if (n < 8) return base + n;
    const float nf = (float)n;
    int large = 8 + (int)(logf(nf / 8.0f) / 4.852030263919617f * 8.0f);
    large = large < 15 ? large : 15;
    return base + large;
}

struct Args { const float* in[16]; float* out; unsigned char* ws; int ph_lo, ph_hi, li, pad; };
typedef const __attribute__((address_space(4))) Args* ArgsP;
__device__ __forceinline__ ArgsP fresh_args() { ArgsP p = (ArgsP)__builtin_amdgcn_kernarg_segment_ptr(); asm volatile("" : "+s"(p)); return p; }
#define FRESH_LANE() ({ int l_ = threadIdx.x & 63; asm volatile("" : "+v"(l_)); l_; })
#ifndef PH_MASK
#define PH_MASK 0x3ff
#endif
#define PH_ON(i) (((PH_MASK) >> (i)) & 1)
#ifndef GEMM_WGM_N4096
#define GEMM_WGM_N4096 4
#endif
#ifndef REPEAT_MASK
#define REPEAT_MASK 0
#endif
#define PH_REP(i) for (int rep_ = 0; rep_ < 1 + (((REPEAT_MASK) >> (i)) & 1); ++rep_)

__global__ void __launch_bounds__(NWAVES * 64, 2) enc_fwd(Args args) {
    extern __shared__ __attribute__((aligned(16))) unsigned char lds[];
    const int wave = __builtin_amdgcn_readfirstlane(threadIdx.x >> 6);
    const int G = gridDim.x, bx = blockIdx.x, vcu = (G % 8 == 0) ? (bx % 8) * (G / 8) + bx / 8 : bx;
    const int gw = vcu * NWAVES + wave, NGW = G * NWAVES;
    LAS unsigned char* ldsl = (LAS unsigned char*)lds;
    volatile LAS unsigned* MISC = (volatile LAS unsigned*)(ldsl + MISC_OFF);
    for (int u = threadIdx.x; u < (LDS_BYTES - LDSCTL_OFF) / 4; u += NWAVES * 64) ((LAS unsigned*)(ldsl + LDSCTL_OFF))[u] = 0u;
    __syncthreads();
    XcdBarrier bar; bar.bar = (unsigned*)((gu32*)(args.ws + WS_CTL) + CW_BAR); bar.x = 0; bar.st = nullptr;
    if (N_LAUNCHES == 1) bar = xcd_barrier_post((unsigned*)((gu32*)(args.ws + WS_CTL) + CW_BAR), MISC + 8);
#define GRID_BAR() do { if (N_LAUNCHES == 1) { xcd_barrier(bar); } } while (0)
    const int lo = args.ph_lo, hi = args.ph_hi;
#define IN(k) (lo <= (k) && (k) < hi)
#define BOTH(k) (IN(k) && IN((k) + 1))

    if (PH_ON(0) && IN(0)) {
        PH_REP(0) {
        ArgsP ap = fresh_args(); unsigned char* ws = ap->ws;
        LAS float* scr = (LAS float*)(ldsl + RING_OFF + wave * 9216);
        constexpr int I_IN = (DM / 64) * (INW / 32), I_OUT = (DM / 64) * (DM / 32), I_UP = (DM / 64) * (FF / 32), I_DN = (FF / 64) * (DM / 32);
        constexpr int I_CM = (DM / 512) * (FF / 32), I_CMI = (DM / 128) * (INW / 32);
        constexpr int I_CMD = (FF / 512) * (DM / 32);
        constexpr int LA0 = I_CM + ((I8P & 1) ? I_CMI : I_IN) + I_OUT + ((I8D & 1) ? I_CMD : I_DN), LA1 = I_CM + ((I8P & 2) ? I_CMI : I_IN) + I_OUT + ((I8D & 2) ? I_CMD : I_DN);
        constexpr int LB0 = I_UP + ((I8P & 1) ? I_IN : 0) + ((I8D & 1) ? I_DN : 0), LB1 = I_UP + ((I8P & 2) ? I_IN : 0) + ((I8D & 2) ? I_DN : 0);
        const int lnp = FRESH_LANE();
        for (int it = gw; it < LA0 + LA1; it += NGW) {
            const int layer = it >= LA0 ? 1 : 0; int r = it - (layer ? LA0 : 0); const bool qin = ((I8P >> layer) & 1) != 0;
            if (r < I_CM) { colmax_item(ap->in[13] + (size_t)layer * DM * FF, FF, ap->in[12] + layer * DM, (unsigned*)(ws + WS_CMAX) + layer * FF, r, lnp); continue; } r -= I_CM;
            if (qin) { if (r < I_CMI) { colmax_item(ap->in[3] + (size_t)layer * DM * INW, INW, ap->in[2] + layer * DM, (unsigned*)(ws + WS_CMAXI) + layer * INW, r, lnp, 128); continue; } r -= I_CMI; }
            else { if (r < I_IN) { transpose_item(ap->in[3] + (size_t)layer * DM * INW, DM, INW, (bf16*)(ws + WS_WIN + layer * SZ_WIN), ap->in[2] + layer * DM, scr, r, lnp); continue; } r -= I_IN; }
            if (r < I_OUT) { transpose_item(ap->in[10] + (size_t)layer * DM * DM, DM, DM, (bf16*)(ws + WS_WOUT + layer * SZ_WOUT), nullptr, scr, r, lnp); continue; } r -= I_OUT;
            if ((I8D >> layer) & 1) colmax_item(ap->in[14] + (size_t)layer * FF * DM, DM, nullptr, (unsigned*)(ws + WS_CMAXD) + layer * DM, r, lnp);
            else transpose_item(ap->in[14] + (size_t)layer * FF * DM, FF, DM, (bf16*)(ws + WS_WDN + layer * SZ_WDN), nullptr, scr, r, lnp);
        }
        { const int gt = bx * (NWAVES * 64) + (int)threadIdx.x; f32x2* rtab = (f32x2*)(ws + WS_ROPE); float* btab = (float*)(ws + WS_BTAB);
          if (gt < 4096) { const int pos = gt >> 5, i = gt & 31; const float inv = (float)pow(10000.0, -(double)i / 32.0); const float ang = (float)pos * inv;
              f32x2 cs; cs.x = cosf(ang); cs.y = sinf(ang); rtab[gt] = cs; }
          else if (gt < 4096 + 3 * 8 * 132) { const int e = gt - 4096, br = e / (8 * 132), h = (e / 132) % 8, k = e % 132; float v = 0.f;
              if (k < 129) { const int rel = (k - 64) << (2 * br); v = ap->in[1][t5_bucket(rel) * 8 + h] * 1.4426950408889634f; }
              btab[e] = v; } }
        { const int ln = FRESH_LANE(); const float* x_in = ap->in[0]; bf16* XB = (bf16*)(ws + WS_HN); float* RS = (float*)(ws + WS_RS);
          for (int m = gw; m < M; m += NGW) { if (I8P & 1) cast_row<true>(x_in + (size_t)m * DM, nullptr, RS + m, ln, (signed char*)(ws + WS_XQ) + (size_t)m * DM, (float*)(ws + WS_RF) + m); else cast_row<false>(x_in + (size_t)m * DM, XB + (size_t)m * DM, RS + m, ln); } }
        GRID_BAR();
        { const int lnq = FRESH_LANE();
          for (int itr = gw; itr < LB0 + LB1; itr += NGW) { const int it = LB0 + LB1 - 1 - itr;
            const int layer = it >= LB0 ? 1 : 0; int r = it - (layer ? LB0 : 0); const unsigned* cm = (const unsigned*)(ws + WS_CMAX) + layer * FF; const bool qin = ((I8P >> layer) & 1) != 0;
            if (r < I_UP) { transpose_item_q(ap->in[13] + (size_t)layer * DM * FF, DM, FF, (signed char*)(ws + WS_WUP + layer * SZ_WUP), ap->in[12] + layer * DM, cm, scr, r, lnq); continue; } r -= I_UP;
            if (qin) { if (r < I_IN) { transpose_item_q(ap->in[3] + (size_t)layer * DM * INW, DM, INW, (signed char*)(ws + WS_WIN + layer * SZ_WIN), ap->in[2] + layer * DM, (const unsigned*)(ws + WS_CMAXI) + layer * INW, scr, r, lnq); continue; } r -= I_IN; }
            transpose_item_q(ap->in[14] + (size_t)layer * FF * DM, FF, DM, (signed char*)(ws + WS_WDN + layer * SZ_WDN), nullptr, (const unsigned*)(ws + WS_CMAXD) + layer * DM, scr, r, lnq, (int*)(ws + WS_CSUM) + layer * DM); } }
        }
        __syncthreads();
    }

    for (int layer = 0; layer < N_LAYERS; ++layer) {
        const int pb = 1 + layer * PH_PER_LAYER;
        if (PH_ON(1) && IN(pb + 0)) {
            PH_REP(1) {
            ArgsP ap = fresh_args(); unsigned char* ws = ap->ws;
            int bxl = bx; asm volatile("" : "+s"(bxl));
            if ((I8P >> layer) & 1) {
            pg8::Gemm g{(const bf16*)(ws + WS_XQ), (const bf16*)(ws + WS_WIN + layer * SZ_WIN), M, INW, DM / 2}; pg8::StaticOrder S; S.init(M, INW, G, bxl);
            pg8::EpiI8P E{(bf16*)(ws + WS_PROJ), INW, (const float*)(ws + WS_RF), (const unsigned*)(ws + WS_CMAXI) + layer * INW};
            pg8::gemm_phase<pg8::EpiI8P, pg8::StaticOrder, true, true, false, true, true>(ldsl + RING_OFF, g, S, E);
            } else {
            pg8::Gemm g{(const bf16*)(ws + WS_HN), (const bf16*)(ws + WS_WIN + layer * SZ_WIN), M, INW, DM}; pg8::StaticOrder S; S.init(M, INW, G, bxl);
            pg8::EpiBf16<0> E{(bf16*)(ws + WS_PROJ), INW, (const float*)(ws + WS_RS)};
            pg8::gemm_phase<pg8::EpiBf16<0>, pg8::StaticOrder, true, true, false, true>(ldsl + RING_OFF, g, S, E);
            }
            }
            if (BOTH(pb + 0)) GRID_BAR();
        }
        if (PH_ON(2) && IN(pb + 1)) {
            PH_REP(2) {
            ArgsP ap = fresh_args(); unsigned char* ws = ap->ws;
            const bf16* PROJ = (const bf16*)(ws + WS_PROJ);
            { const float* kg = ap->in[6] + layer * 128; const float* cw = ap->in[4] + layer * 3 * 1024; const float* gbg = ap->in[8] + layer * 1024;
              bf16* KR = (bf16*)(ws + WS_KR); bf16* MIX = (bf16*)(ws + WS_MIX); const f32x2* rtab = (const f32x2*)(ws + WS_ROPE);
              const int ln = FRESH_LANE(); for (int m = gw; m < M; m += NGW) { const bf16* prow = PROJ + (size_t)m * INW; const int t = m & (SEQ - 1);
                krope_row(prow, KR + (size_t)m * 512, kg, rtab, t, ln);
                conv_row(prow, MIX + (size_t)m * DM, cw, gbg, t, ln); } }
            __syncthreads();
            { const float* btab = (const float*)(ws + WS_BTAB); bf16* OA = (bf16*)(ws + WS_OA); float* LSE = (float*)(ws + WS_LSE);
              for (int R = bx; R < 6144 / att::MIXA_RUN; R += G) { const int rn0 = (R & 15) * att::MIXA_RUN, tt = R >> 4, br = tt % 3, bh = tt / 3, sh = 2 * br;
                att::mixa_run(bh >> 3, bh & 7, br, rn0 >> (7 - sh), rn0 & ((128 >> sh) - 1), PROJ, btab, OA, LSE, (char*)lds + RING_OFF); } }
            }
            if (BOTH(pb + 1)) GRID_BAR();
        }
        if (PH_ON(3) && IN(pb + 2)) {
            PH_REP(3) {
            ArgsP ap = fresh_args(); unsigned char* ws = ap->ws;
            const float* qg = ap->in[5] + layer * 128; const bf16* PROJ = (const bf16*)(ws + WS_PROJ); const bf16* KR = (const bf16*)(ws + WS_KR); bf16* OC = (bf16*)(ws + WS_OC);
            const att::f32x2a* rtab = (const att::f32x2a*)(ws + WS_ROPE);
            bool fastsm;
            { const float* kg = ap->in[6] + layer * 128; float gq = 0.f, gk = 0.f;
              for (int i_ = 0; i_ < 128; ++i_) { gq = fmaxf(gq, fabsf(qg[i_])); gk = fmaxf(gk, fabsf(kg[i_])); }
              const float bound = 128.0f * att::SCALE * 1.4426950408889634f * 1.02f * gq * gk;
              fastsm = __builtin_amdgcn_readfirstlane((int)(bound <= 64.0f)) != 0; }
            if (wave >= 4) __builtin_amdgcn_s_setprio(1);
            if (fastsm) {
            for (int i = 0; ; ++i) { const int U = (G == 256) ? (vcu >> 5) * 128 + i * 32 + (vcu & 31) : i * G + bx; if (i * G >= 1024 || U >= 1024) break;
                const int xk = U >> 7, g4 = (U >> 5) & 3, qb = U & 31, b = xk >> 2, kvh = xk & 3, h = kvh * 4 + g4;
                att::attn_dense_body<true>(PROJ + ((size_t)b * SEQ + qb * 256) * INW + COL_QC + h * 128, KR + (size_t)b * SEQ * 512 + kvh * 128, PROJ + (size_t)b * SEQ * INW + COL_VC + kvh * 128,
                                     OC + ((size_t)b * SEQ + qb * 256) * 2048 + h * 128, qb * 256, qg, rtab, (char*)lds + RING_OFF); }
            } else {
            for (int i = 0; ; ++i) { const int U = (G == 256) ? (vcu >> 5) * 128 + i * 32 + (vcu & 31) : i * G + bx; if (i * G >= 1024 || U >= 1024) break;
                const int xk = U >> 7, g4 = (U >> 5) & 3, qb = U & 31, b = xk >> 2, kvh = xk & 3, h = kvh * 4 + g4;
                att::attn_dense_body<false>(PROJ + ((size_t)b * SEQ + qb * 256) * INW + COL_QC + h * 128, KR + (size_t)b * SEQ * 512 + kvh * 128, PROJ + (size_t)b * SEQ * INW + COL_VC + kvh * 128,
                                     OC + ((size_t)b * SEQ + qb * 256) * 2048 + h * 128, qb * 256, qg, rtab, (char*)lds + RING_OFF); }
            }
            __builtin_amdgcn_s_setprio(0);
            }
            if (BOTH(pb + 2)) GRID_BAR();
        }
        if (PH_ON(4) && IN(pb + 3)) {
            PH_REP(4) {
            ArgsP ap = fresh_args(); unsigned char* ws = ap->ws;
            const float* ga = ap->in[7] + layer * 1024; const float* gc = ap->in[9] + layer * 2048;
            const bf16* OA = (const bf16*)(ws + WS_OA); const float* LSE = (const float*)(ws + WS_LSE); const bf16* OC = (const bf16*)(ws + WS_OC); bf16* MIX = (bf16*)(ws + WS_MIX);
            { const int ln = FRESH_LANE(); for (int m = gw; m < M; m += NGW) mix_row(OA, LSE, OC, MIX + (size_t)m * DM, ga, gc, m, ln); }
            }
            if (BOTH(pb + 3)) GRID_BAR();
        }
        if (PH_ON(5) && IN(pb + 4)) {
            PH_REP(5) {
            ArgsP ap = fresh_args(); unsigned char* ws = ap->ws;
            pg8::Gemm g{(const bf16*)(ws + WS_MIX), (const bf16*)(ws + WS_WOUT + layer * SZ_WOUT), M, DM, DM}; pg8::StaticOrder S; S.init(M, DM, G, bx, GEMM_WGM_N4096);
            pg8::EpiBf16<0> E{(bf16*)(ws + WS_Y), DM, nullptr};
            pg8::gemm_phase<pg8::EpiBf16<0>, pg8::StaticOrder, true, true, false, true>(ldsl + RING_OFF, g, S, E);
            }
            if (BOTH(pb + 4)) GRID_BAR();
        }
        if (PH_ON(6) && IN(pb + 5)) {
            PH_REP(6) {
            ArgsP ap = fresh_args(); unsigned char* ws = ap->ws;
            const float* gpost = ap->in[11] + layer * DM; const bf16* Y = (const bf16*)(ws + WS_Y); bf16* XB = (bf16*)(ws + WS_HN); float* RS = (float*)(ws + WS_RS); signed char* XQ = (signed char*)(ws + WS_XQ); float* RF = (float*)(ws + WS_RF);
            unsigned* RMAX = (unsigned*)(ws + WS_RMAX);
            { const int ln = FRESH_LANE();
              for (int m = gw; m < M; m += NGW) { resid_row<false, false, true>(Y + (size_t)m * DM, XB + (size_t)m * DM, nullptr, XB + (size_t)m * DM, RS + m, gpost, EPS, ln, XQ + (size_t)m * DM, RF + m); if (ln == 0) RMAX[m] = 0u; } }
            }
            if (BOTH(pb + 5)) GRID_BAR();
        }
        if (PH_ON(7) && IN(pb + 6)) {
            PH_REP(7) {
            ArgsP ap = fresh_args(); unsigned char* ws = ap->ws;
            pg8::Gemm g{(const bf16*)(ws + WS_XQ), (const bf16*)(ws + WS_WUP + layer * SZ_WUP), M, FF, DM / 2}; pg8::StaticOrder S; S.init(M, FF, G, bx);
            pg8::EpiI8H E{(bf16*)(ws + WS_H), FF, (const unsigned*)(ws + WS_CMAX) + layer * FF, ((I8D >> layer) & 1) ? (unsigned*)(ws + WS_RMAX) : nullptr};
            pg8::gemm_phase<pg8::EpiI8H, pg8::StaticOrder, true, true, false, true, true>(ldsl + RING_OFF, g, S, E);
            }
            if (BOTH(pb + 6)) GRID_BAR();
        }
        if (PH_ON(8) && IN(pb + 7)) {
            PH_REP(8) {
            ArgsP ap = fresh_args(); unsigned char* ws = ap->ws;
            int bxl = bx; asm volatile("" : "+s"(bxl));
            if ((I8D >> layer) & 1) {
            { const bf16* H = (const bf16*)(ws + WS_H); signed char* HQ = (signed char*)(ws + WS_HQ); const unsigned* RMAX = (const unsigned*)(ws + WS_RMAX);
              int tq = threadIdx.x; asm volatile("" : "+v"(tq));
              const int r = tq >> 3, b16 = tq & 7;
              for (int item = bx; item < (M / 256) * (FF / 128); item += G) { const int pm = item / (FF / 128), kk = item - pm * (FF / 128);
                  const bf16* src = H + (((size_t)pm * (FF / 64) + kk * 2 + (b16 >> 2)) * 256 + r) * 64 + (b16 & 3) * 16; signed char* dst = HQ + (((size_t)pm * (FF / 128) + kk) * 256 + r) * 128 + b16 * 16;
                  v4u lo[4], hi[4]; float inv[4];
#pragma unroll
                  for (int i = 0; i < 4; ++i) { lo[i] = *(const GAS v4u*)(src + i * 64 * 64); hi[i] = *(const GAS v4u*)(src + i * 64 * 64 + 8);
                      const float tm = __uint_as_float(RMAX[pm * 256 + r + 64 * i]); inv[i] = 255.0f / fmaxf(tm * tm * 1.0078125f, 1e-30f); }
#pragma unroll
                  for (int i = 0; i < 4; ++i) { float a[8], b[8]; unpack8(lo[i], a); unpack8(hi[i], b); v4u o;
                      o.x = pkq4(q8u(a[0] * inv[i]), q8u(a[1] * inv[i]), q8u(a[2] * inv[i]), q8u(a[3] * inv[i])); o.y = pkq4(q8u(a[4] * inv[i]), q8u(a[5] * inv[i]), q8u(a[6] * inv[i]), q8u(a[7] * inv[i]));
                      o.z = pkq4(q8u(b[0] * inv[i]), q8u(b[1] * inv[i]), q8u(b[2] * inv[i]), q8u(b[3] * inv[i])); o.w = pkq4(q8u(b[4] * inv[i]), q8u(b[5] * inv[i]), q8u(b[6] * inv[i]), q8u(b[7] * inv[i]));
                      *(GAS v4u*)(dst + i * 64 * 128) = o; } } }
            GRID_BAR();
            pg8::Gemm g{(const bf16*)(ws + WS_HQ), (const bf16*)(ws + WS_WDN + layer * SZ_WDN), M, DM, FF / 2}; pg8::StaticOrder S; S.init(M, DM, G, bxl, GEMM_WGM_N4096);
            pg8::EpiI8D E{(bf16*)(ws + WS_Y), DM, (const unsigned*)(ws + WS_CMAXD) + layer * DM, (const int*)(ws + WS_CSUM) + layer * DM};
            pg8::gemm_phase<pg8::EpiI8D, pg8::StaticOrder, true, true, true, true, true>(ldsl + RING_OFF, g, S, E);
            } else {
            pg8::Gemm g{(const bf16*)(ws + WS_H), (const bf16*)(ws + WS_WDN + layer * SZ_WDN), M, DM, FF}; pg8::StaticOrder S; S.init(M, DM, G, bxl, GEMM_WGM_N4096);
            pg8::EpiBf16<0> E{(bf16*)(ws + WS_Y), DM, nullptr};
            pg8::gemm_phase<pg8::EpiBf16<0>, pg8::StaticOrder, true, true, true, true>(ldsl + RING_OFF, g, S, E);
            }
            }
            if (BOTH(pb + 7)) GRID_BAR();
        }
        if (PH_ON(9) && IN(pb + 8)) {
            PH_REP(9) {
            ArgsP ap = fresh_args(); unsigned char* ws = ap->ws; float* out = ap->out;
            const float* gpost = ap->in[15] + layer * DM; const bf16* Y = (const bf16*)(ws + WS_Y); bf16* XB = (bf16*)(ws + WS_HN); float* RS = (float*)(ws + WS_RS); float* RF = (float*)(ws + WS_RF); signed char* XQ = (signed char*)(ws + WS_XQ); const unsigned* RMAX = (const unsigned*)(ws + WS_RMAX);
            { const int ln = FRESH_LANE();
              if (layer + 1 < N_LAYERS) { for (int m = gw; m < M; m += NGW) { const float r_ = RF[m], r2_ = r_ * r_; float e4_ = r2_ * r2_; if ((I8D >> layer) & 1) { const float tm_ = __uint_as_float(RMAX[m]), hs_ = fmaxf(tm_ * tm_ * 1.0078125f, 1e-30f) * (1.0f / 255.0f); e4_ *= hs_ * hs_; } if ((I8P >> (layer + 1)) & 1) resid_row<false, false, true>(Y + (size_t)m * DM, XB + (size_t)m * DM, nullptr, XB + (size_t)m * DM, RS + m, gpost, EPS / e4_, ln, XQ + (size_t)m * DM, RF + m);
                  else resid_row<false, false>(Y + (size_t)m * DM, XB + (size_t)m * DM, nullptr, XB + (size_t)m * DM, RS + m, gpost, EPS / e4_, ln); } }
              else { for (int m = gw; m < M; m += NGW) { const float r_ = RF[m], r2_ = r_ * r_; float e4_ = r2_ * r2_; if ((I8D >> layer) & 1) { const float tm_ = __uint_as_float(RMAX[m]), hs_ = fmaxf(tm_ * tm_ * 1.0078125f, 1e-30f) * (1.0f / 255.0f); e4_ *= hs_ * hs_; } resid_row<false, true>(Y + (size_t)m * DM, XB + (size_t)m * DM, out + (size_t)m * DM, nullptr, nullptr, gpost, EPS / e4_, ln); } } }
            }
            if (BOTH(pb + 8)) GRID_BAR();
        }
    }
#undef IN
#undef BOTH
#undef GRID_BAR
}

extern "C" void kernel_launch(void* const* d_in, const int* in_sizes, int n_in, void* d_out, int out_size, void* d_ws, size_t ws_size, hipStream_t stream) {
    static int grid = 0;
    if (grid == 0) {
        if (n_in != 16 || in_sizes[0] != M * DM || out_size != M * DM || ws_size < WS_END) {
            fprintf(stderr, "kernel_launch: shape mismatch n_in %d in0 %d out %d ws %zu (need %zu); nothing launched\n", n_in, n_in > 0 ? in_sizes[0] : -1, out_size, ws_size, (size_t)WS_END); grid = -1; return; }
        int dev = 0, cus = 0, per_cu = 0;
        if (hipGetDevice(&dev) != hipSuccess || hipDeviceGetAttribute(&cus, hipDeviceAttributeMultiprocessorCount, dev) != hipSuccess) { grid = -1; return; }
        if (hipFuncSetAttribute((const void*)enc_fwd, hipFuncAttributeMaxDynamicSharedMemorySize, LDS_BYTES) != hipSuccess) { fprintf(stderr, "kernel_launch: hipFuncSetAttribute failed\n"); grid = -1; return; }
        if (hipOccupancyMaxActiveBlocksPerMultiprocessor(&per_cu, (const void*)enc_fwd, NWAVES * 64, LDS_BYTES) != hipSuccess || per_cu < 1) {
            fprintf(stderr, "kernel_launch: occupancy query reports %d workgroups per CU\n", per_cu); }
        (void)hipGetLastError();
        grid = cus;
    }
    if (grid < 0) return;
    if (hipMemsetAsync((char*)d_ws + WS_CTL, 0, CTL_ZERO_BYTES, stream) != hipSuccess) return;
    Args a{};
    for (int i = 0; i < 16; ++i) a.in[i] = (const float*)d_in[i];
    a.out = (float*)d_out; a.ws = (unsigned char*)d_ws;
    for (int li = 0; li < N_LAUNCHES; ++li) {
        a.ph_lo = (N_LAUNCHES == 1) ? 0 : li; a.ph_hi = (N_LAUNCHES == 1) ? N_PHASES : li + 1; a.li = li; a.pad = 0;
        hipLaunchKernelGGL(enc_fwd, dim3(grid), dim3(NWAVES * 64), LDS_BYTES, stream, a);
        const hipError_t le = hipPeekAtLastError();
        if (le != hipSuccess) { fprintf(stderr, "kernel_launch: launch %d failed: %s\n", li, hipGetErrorName(le)); break; }
    }
}
```
